# Optimizing an MI355X kernel written in HIP

```python
import jax, jax.numpy as jnp
from jax import lax
import numpy as np

D_MODEL = 1024
BATCH = 2
SEQ = 8192
DEPTH = 1
DEC_BATCH = 16
DEC_SEQ = 2048
PAST_LEN = 128

PLE_DIM = 256
GRID_W = 64
WIN_R = 8
WIN_C = 16
Q_BLOCK_C = 16
K_BLOCK_C = 32
NA_HEADS = 8
NA_HEAD_DIM = 64
NA_WIDTH = NA_HEADS * NA_HEAD_DIM
RW_HEADS = 8
RW_HEAD_DIM = 64
RW_WIDTH = RW_HEADS * RW_HEAD_DIM
DECAY_RANK = 64
AAA_RANK = 64
GATE_RANK = 128
D_FF = 4 * D_MODEL
N_BRANCH = 2
EPS = 1e-6
GN_EPS = 64e-5
DECAY_SCALE = 0.606531
NEG_INF = -1e30

NA_COLS = 3 * NA_WIDTH
RW_COLS = 3 * RW_WIDTH + 2 * DECAY_RANK + AAA_RANK + GATE_RANK
GATE_COLS = N_BRANCH * D_MODEL
IN_COLS = NA_COLS + RW_COLS + GATE_COLS

kernel_name = "hybrid_natten_rwkv7_bidir_encoder"


def rms_norm(x, g):
    xf = x.astype(jnp.float32)
    y = xf * lax.rsqrt(jnp.mean(xf * xf, axis=-1, keepdims=True) + EPS)
    return (y * g.astype(jnp.float32)).astype(x.dtype)


def neighbourhood_attention(q, k, v, rel_bias):
    B, L, H, dh = q.shape
    rows = L // GRID_W
    kr = min(WIN_R, rows)
    n_cb = GRID_W // Q_BLOCK_C
    nk = kr * K_BLOCK_C
    row_start = np.clip(np.arange(rows) - kr // 2, 0, rows - kr)
    key_rows = row_start[:, None] + np.arange(kr)[None, :]
    blk_start = np.clip(np.arange(n_cb) * Q_BLOCK_C - WIN_C // 2, 0, GRID_W - K_BLOCK_C)
    key_cols = blk_start[:, None] + np.arange(K_BLOCK_C)[None, :]
    idx = (key_rows[:, None, :, None] * GRID_W + key_cols[None, :, None, :]).reshape(rows, n_cb, nk)
    q_cols = np.arange(n_cb)[:, None] * Q_BLOCK_C + np.arange(Q_BLOCK_C)[None, :]
    col_start = np.clip(q_cols - WIN_C // 2, 0, GRID_W - WIN_C)
    in_win = (key_cols[:, None, :] >= col_start[..., None]) & (key_cols[:, None, :] < col_start[..., None] + WIN_C)
    mask = np.broadcast_to(in_win[:, :, None, :], (n_cb, Q_BLOCK_C, kr, K_BLOCK_C))
    dr_idx = key_rows - np.arange(rows)[:, None] + WIN_R - 1
    dc_idx = np.clip(key_cols[:, None, :] - q_cols[..., None] + WIN_C - 1, 0, 2 * WIN_C - 2)
    bias = rel_bias.astype(jnp.float32)[:, dr_idx[:, None, None, :, None], dc_idx[None, :, :, None, :]]
    bias = jnp.where(mask[None, None], bias, NEG_INF).reshape(H, rows, n_cb, Q_BLOCK_C, nk)
    qb = q.reshape(B, rows, n_cb, Q_BLOCK_C, H, dh)
    kg = k[:, idx]
    vg = v[:, idx]
    s = jnp.einsum('brcqhd,brckhd->bhrcqk', qb, kg).astype(jnp.float32) * (dh ** -0.5) + bias[None]
    prob = jax.nn.softmax(s, axis=-1).astype(v.dtype)
    o = jnp.einsum('bhrcqk,brckhd->brcqhd', prob, vg)
    return o.reshape(B, L, H, dh)


def centred_shift(u, w):
    prev = jnp.pad(u[:, :-1], ((0, 0), (1, 0), (0, 0)))
    nxt = jnp.pad(u[:, 1:], ((0, 0), (0, 1), (0, 0)))
    return prev * w[0] + u * w[1] + nxt * w[2]


def rwkv7_bidir(u, w0_f, w_up_f, w0_b, w_up_b, a0, a_up, g_up, k_k, k_a, r_k, ln_x_w, ln_x_b):
    B, L, _ = u.shape
    f32 = lambda t: t.astype(jnp.float32)
    splits = np.cumsum([RW_WIDTH, RW_WIDTH, RW_WIDTH, DECAY_RANK, DECAY_RANK, AAA_RANK])
    r, k, v, dwf, dwb, da, dg = jnp.split(u, splits, axis=-1)
    decay_f = jnp.exp(-DECAY_SCALE * jax.nn.sigmoid(f32(w0_f + jnp.tanh(dwf) @ w_up_f)))
    decay_b = jnp.exp(-DECAY_SCALE * jax.nn.sigmoid(f32(w0_b + jnp.tanh(dwb) @ w_up_b)))
    a = jax.nn.sigmoid(f32(a0 + da @ a_up))
    g = jax.nn.sigmoid(dg) @ g_up
    heads = lambda t: t.reshape(B, L, RW_HEADS, RW_HEAD_DIM)
    kk = heads(f32(k * k_k))
    kk = kk / jnp.maximum(jnp.sqrt(jnp.sum(kk * kk, axis=-1, keepdims=True)), 1e-12)
    kt = f32(k) * (1.0 + (a - 1.0) * f32(k_a))
    rh, kh, vh, ah = heads(f32(r)), heads(kt), heads(f32(v)), heads(a)

    def step(S, inp):
        r_t, w_t, k_t, v_t, kk_t, a_t = inp
        sa = jnp.einsum('bhvk,bhk->bhv', S, -kk_t)
        S = S * w_t[:, :, None, :] + sa[..., None] * (kk_t * a_t)[:, :, None, :] + v_t[..., None] * k_t[:, :, None, :]
        return S, jnp.einsum('bhvk,bhk->bhv', S, r_t)

    tm = lambda t: jnp.moveaxis(t, 1, 0)
    S0 = jnp.zeros((B, RW_HEADS, RW_HEAD_DIM, RW_HEAD_DIM), jnp.float32)
    r_tm, k_tm, v_tm, kk_tm, a_tm = tm(rh), tm(kh), tm(vh), tm(kk), tm(ah)
    _, y_f = lax.scan(step, S0, (r_tm, tm(heads(decay_f)), k_tm, v_tm, kk_tm, a_tm))
    _, y_b = lax.scan(step, S0, (r_tm, tm(heads(decay_b)), k_tm, v_tm, kk_tm, a_tm), reverse=True)
    o = jnp.moveaxis(y_f + y_b, 0, 1)
    mu = jnp.mean(o, axis=-1, keepdims=True)
    var = jnp.mean(jnp.square(o - mu), axis=-1, keepdims=True)
    o = ((o - mu) * lax.rsqrt(var + GN_EPS)).reshape(B, L, RW_WIDTH) * f32(ln_x_w) + f32(ln_x_b)
    bonus = jnp.sum(rh * kh * f32(r_k), axis=-1, keepdims=True) * vh
    out = (o + bonus.reshape(B, L, RW_WIDTH)) * f32(g)
    return out.astype(u.dtype)


def encoder_layer(x, p, g_mix, w_in, conv_w, q_gain, k_gain, rel_bias, w0_f, w_up_f, w0_b, w_up_b,
                  a0, a_up, g_up, k_k, k_a, r_k, ln_x_w, ln_x_b, w_a_out, w_b_out, w_o,
                  g_ffn, w_ff1, w_ff2, w_ple, g_ple, w_pgate):
    B, L, _ = x.shape
    n = rms_norm(x, g_mix)
    z = n @ w_in
    z_na, z_rw, z_gate = jnp.split(z, [NA_COLS, NA_COLS + RW_COLS], axis=-1)
    q, k, v = [t.reshape(B, L, NA_HEADS, NA_HEAD_DIM) for t in jnp.split(z_na, 3, axis=-1)]
    q = rms_norm(q, q_gain)
    k = rms_norm(k, k_gain)
    y_a = neighbourhood_attention(q, k, v, rel_bias).reshape(B, L, NA_WIDTH)
    y_b = rwkv7_bidir(centred_shift(z_rw, conv_w), w0_f, w_up_f, w0_b, w_up_b, a0, a_up, g_up,
                      k_k, k_a, r_k, ln_x_w, ln_x_b)
    gate_a, gate_b = jnp.split(z_gate, N_BRANCH, axis=-1)
    merged = jax.nn.sigmoid(gate_a) * (y_a @ w_a_out) + jax.nn.sigmoid(gate_b) * (y_b @ w_b_out)
    h = x + merged @ w_o
    h = h + jnp.square(jax.nn.relu(rms_norm(h, g_ffn) @ w_ff1)) @ w_ff2
    h = h + jax.nn.sigmoid(rms_norm(h, g_ple) @ w_pgate) * (p @ w_ple)
    return h


def setup_inputs(seed: int = 0) -> dict:
    key = jax.random.key(seed)
    ks = jax.random.split(key, 32)
    nrm = lambda k, shape, scale: jax.random.normal(k, shape, jnp.float32) * scale
    conv_base = jnp.array([0.25, 0.5, 0.25], jnp.float32)[None, :, None]
    return {
        'x_prompt': nrm(ks[0], (BATCH, SEQ, D_MODEL), 1.0),
        'x_sample': nrm(ks[1], (DEC_BATCH, DEC_SEQ, D_MODEL), 1.0),
        'p_prompt': nrm(ks[2], (DEPTH, BATCH, SEQ, PLE_DIM), 1.0),
        'p_sample': nrm(ks[3], (DEPTH, DEC_BATCH, DEC_SEQ, PLE_DIM), 1.0),
        'g_mix': 1.0 + nrm(ks[4], (DEPTH, D_MODEL), 0.02),
        'w_in': nrm(ks[5], (DEPTH, D_MODEL, IN_COLS), D_MODEL ** -0.5),
        'conv_w': conv_base + nrm(ks[6], (DEPTH, 3, RW_COLS), 0.05),
        'q_gain': 1.0 + nrm(ks[7], (DEPTH, NA_HEAD_DIM), 0.02),
        'k_gain': 1.0 + nrm(ks[8], (DEPTH, NA_HEAD_DIM), 0.02),
        'rel_bias': nrm(ks[9], (DEPTH, NA_HEADS, 2 * WIN_R - 1, 2 * WIN_C - 1), 0.02),
        'w0_f': -1.0 + nrm(ks[10], (DEPTH, RW_WIDTH), 0.5),
        'w_up_f': nrm(ks[11], (DEPTH, DECAY_RANK, RW_WIDTH), 0.1 * DECAY_RANK ** -0.5),
        'w0_b': -1.0 + nrm(ks[12], (DEPTH, RW_WIDTH), 0.5),
        'w_up_b': nrm(ks[13], (DEPTH, DECAY_RANK, RW_WIDTH), 0.1 * DECAY_RANK ** -0.5),
        'a0': nrm(ks[14], (DEPTH, RW_WIDTH), 0.1),
        'a_up': nrm(ks[15], (DEPTH, AAA_RANK, RW_WIDTH), 0.1 * AAA_RANK ** -0.5),
        'g_up': nrm(ks[16], (DEPTH, GATE_RANK, RW_WIDTH), GATE_RANK ** -0.5),
        'k_k': 0.85 + nrm(ks[17], (DEPTH, RW_WIDTH), 0.02),
        'k_a': 1.0 + nrm(ks[18], (DEPTH, RW_WIDTH), 0.02),
        'r_k': nrm(ks[19], (DEPTH, RW_HEADS, RW_HEAD_DIM), 0.1),
        'ln_x_w': 1.0 + nrm(ks[20], (DEPTH, RW_WIDTH), 0.02),
        'ln_x_b': nrm(ks[21], (DEPTH, RW_WIDTH), 0.01),
        'w_a_out': nrm(ks[22], (DEPTH, NA_WIDTH, D_MODEL), NA_WIDTH ** -0.5),
        'w_b_out': nrm(ks[23], (DEPTH, RW_WIDTH, D_MODEL), RW_WIDTH ** -0.5),
        'w_o': nrm(ks[24], (DEPTH, D_MODEL, D_MODEL), D_MODEL ** -0.5),
        'g_ffn': 1.0 + nrm(ks[25], (DEPTH, D_MODEL), 0.02),
        'w_ff1': nrm(ks[26], (DEPTH, D_MODEL, D_FF), D_MODEL ** -0.5),
        'w_ff2': nrm(ks[27], (DEPTH, D_FF, D_MODEL), D_FF ** -0.5),
        'w_ple': nrm(ks[28], (DEPTH, PLE_DIM, D_MODEL), PLE_DIM ** -0.5),
        'g_ple': 1.0 + nrm(ks[29], (DEPTH, D_MODEL), 0.02),
        'w_pgate': nrm(ks[30], (DEPTH, D_MODEL, D_MODEL), D_MODEL ** -0.5),
    }


def reference(x_prompt, x_sample, p_prompt, p_sample, g_mix, w_in, conv_w, q_gain, k_gain, rel_bias,
              w0_f, w_up_f, w0_b, w_up_b, a0, a_up, g_up, k_k, k_a, r_k, ln_x_w, ln_x_b,
              w_a_out, w_b_out, w_o, g_ffn, w_ff1, w_ff2, w_ple, g_ple, w_pgate):
    def run(h, p):
        for i in range(DEPTH):
            h = encoder_layer(h, p[i], g_mix[i], w_in[i], conv_w[i], q_gain[i], k_gain[i], rel_bias[i],
                              w0_f[i], w_up_f[i], w0_b[i], w_up_b[i], a0[i], a_up[i], g_up[i],
                              k_k[i], k_a[i], r_k[i], ln_x_w[i], ln_x_b[i], w_a_out[i], w_b_out[i], w_o[i],
                              g_ffn[i], w_ff1[i], w_ff2[i], w_ple[i], g_ple[i], w_pgate[i])
        return h
    y_prompt = run(x_prompt, p_prompt)
    y_sample = run(x_sample, p_sample)
    return (y_prompt, y_sample)
```

```cpp
#include <hip/hip_runtime.h>
#include <hip/hip_cooperative_groups.h>
#include <cstdio>
namespace pg8 {
#define PG8_LAS __attribute__((address_space(3)))
typedef unsigned short bf16_t;
typedef short bf16x8 __attribute__((ext_vector_type(8)));
typedef float f32x4 __attribute__((ext_vector_type(4)));
typedef unsigned u32x4 __attribute__((ext_vector_type(4)));
constexpr int BM = 256, BK = 64, HALF = 128, HTB = HALF * BK * 2  , STAGE_BYTES = 8 * HTB, NXCD = 8, WGM = 8;

__host__ __device__ __forceinline__ int lds_byte(int r, int c) { const int st = (r >> 4) * 2 + (c >> 5), rr = r & 15, cc = c & 31, ob = rr * 64 + cc * 2; return st * 1024 + (ob ^ (((ob >> 9) & 1) << 5)); }
__host__ __device__ __forceinline__ void stage_rc(int b, int& R, int& C) { const int st = b / 1024, sb = b % 1024, swz = sb ^ (((sb >> 9) & 1) << 5); R = (st >> 1) * 16 + swz / 64; C = (st & 1) * 32 + (swz % 64) / 2; }
__host__ __device__ __forceinline__ int perm32(int rho) { const int n = rho >> 4, i = rho & 15; return 8 * (i >> 2) + 4 * n + (i & 3); }

struct Unit { int pm, pn; };
struct Gemm { const bf16_t* A; const bf16_t* Bt; int M, N, K; };

struct StaticOrder {
    int nM, nN, nwg, G, c;
    __host__ __device__ void init(int M, int N, int G_, int c_) { nM = M / BM; nN = N / BM; nwg = nM * nN; G = G_; c = c_; }
    __host__ __device__ bool next(int i, Unit& u) const {
        const long L = (long)i * G + c; if (L >= nwg) return false;
        int wgid = (int)L; { const int q = nwg / NXCD, r = nwg % NXCD, xcd = wgid % NXCD, off = wgid / NXCD; wgid = (xcd < r ? xcd * (q + 1) : r * (q + 1) + (xcd - r) * q) + off; }
        const int nig = WGM * nN, gid = wgid / nig, fm = gid * WGM, gsz = (nM - fm) < WGM ? (nM - fm) : WGM;
        u.pm = fm + ((wgid % nig) % gsz); u.pn = (wgid % nig) / gsz; return true;
    }
    __device__ __forceinline__ void a_ready(const Unit&) const {}
    __device__ __forceinline__ void done(const Unit&) const {}
};
typedef __bf16 bf16x2v_t __attribute__((ext_vector_type(2)));
typedef float f32x2 __attribute__((ext_vector_type(2)));
__device__ __forceinline__ unsigned cvt_pk_bf16(float lo, float hi) { const f32x2 v = (f32x2){lo, hi}; const bf16x2v_t b = __builtin_convertvector(v, bf16x2v_t); return __builtin_bit_cast(unsigned, b); }
template <class Epi, class Sched, bool STAMP = false>
__device__ __forceinline__ void gemm_phase(PG8_LAS unsigned char* lds, const Gemm g, const Sched& S, const Epi& E, unsigned long long* stamps, const int tid) {
    const int wid = __builtin_amdgcn_readfirstlane(tid >> 6), lane = tid & 63, wr = wid >> 2, wc = wid & 3, fr = lane & 15, fq = lane >> 4;
    const int K = g.K, nt = K / BK;
    int ts_lo = 0, ts_hi = 0, nts = 0; const unsigned long long rt_entry = STAMP ? (unsigned long long)wall_clock64() : 0ull;
#define PG8_STAMP() do { if (STAMP && wid == 0 && nts < 64) { const unsigned long long _c = (unsigned long long)clock64(); \
        ts_lo = (lane == nts) ? (int)(unsigned)_c : ts_lo; ts_hi = (lane == nts) ? (int)(unsigned)(_c >> 32) : ts_hi; ++nts; } } while (0)
    PG8_STAMP();
    unsigned voffA[2], voffB[2];
#pragma unroll
    for (int i = 0; i < 2; ++i) { int R, C; stage_rc(tid * 16 + i * 8192, R, C); const int Rb = Epi::PERM ? ((R & ~31) + perm32(R & 31)) : R;
        voffA[i] = (unsigned)(R * K + C) * 2u; voffB[i] = (unsigned)(Rb * K + C) * 2u; }
    const size_t kstep = (size_t)(BK * 2);
    const size_t hstep = (size_t)HALF * K * 2;
    const size_t tstep = 2 * hstep;
    const unsigned ldsw = (unsigned)wid * 1024u;
    const int aoff = lds_byte(wr * 64 + fr, fq * 8), boff = lds_byte(wc * 32 + fr, fq * 8);
#define PG8_SA(b, h) (((b) * 2 + (h)) * HTB)
#define PG8_SB(b, h) ((4 + (b) * 2 + (h)) * HTB)
#define PG8_STAGE(bufoff, gbase, voff) do { _Pragma("unroll") for (int _i = 0; _i < 2; ++_i) \
        __builtin_amdgcn_global_load_lds((const unsigned*)((const char*)(gbase) + (voff)[_i]), (PG8_LAS unsigned*)(lds + (bufoff) + ldsw + _i * 8192), 16, 0, 0); } while (0)
#define PG8_LDA(dst, b, h) do { _Pragma("unroll") for (int m = 0; m < 4; ++m) _Pragma("unroll") for (int k = 0; k < 2; ++k) dst[m][k] = *(const PG8_LAS bf16x8*)(lds + PG8_SA(b, h) + aoff + m * 2048 + k * 1024); } while (0)
#define PG8_LDB(dst, b, h) do { _Pragma("unroll") for (int n = 0; n < 2; ++n) _Pragma("unroll") for (int k = 0; k < 2; ++k) dst[n][k] = *(const PG8_LAS bf16x8*)(lds + PG8_SB(b, h) + boff + n * 2048 + k * 1024); } while (0)
#define PG8_MMA(ai, bj, At, Bt) do { __builtin_amdgcn_s_setprio(1); _Pragma("unroll") for (int m = 0; m < 4; ++m) _Pragma("unroll") for (int n = 0; n < 2; ++n) _Pragma("unroll") for (int k = 0; k < 2; ++k) \
        acc[ai][bj][m][n] = __builtin_amdgcn_mfma_f32_16x16x32_bf16(Bt[n][k], At[m][k], acc[ai][bj][m][n], 0, 0, 0); __builtin_amdgcn_s_setprio(0); } while (0)
#define PG8_WAIT_V(n) asm volatile("s_waitcnt vmcnt(" #n ")" ::: "memory")
#define PG8_WAIT_L(n) asm volatile("s_waitcnt lgkmcnt(" #n ")" ::: "memory")
#define PG8_BAR __builtin_amdgcn_s_barrier()
#define PG8_SCHED __builtin_amdgcn_sched_barrier(0)
    Unit cur, nxt; int ui = 0;
    if (!S.next(0, cur)) return;
    f32x4 acc[2][2][4][2];
#pragma unroll
    for (int a = 0; a < 2; ++a)
#pragma unroll
        for (int b = 0; b < 2; ++b)
#pragma unroll
            for (int m = 0; m < 4; ++m)
#pragma unroll
                for (int n = 0; n < 2; ++n) acc[a][b][m][n] = (f32x4){0.f, 0.f, 0.f, 0.f};
    bf16x8 At[4][2], B0[2][2], B1[2][2];
    const char* cA = (const char*)g.A + (size_t)cur.pm * tstep; const char* cB = (const char*)g.Bt + (size_t)cur.pn * tstep;
    S.a_ready(cur);
    PG8_STAGE(PG8_SB(0, 0), cB, voffB); PG8_STAGE(PG8_SA(0, 0), cA, voffA); PG8_STAGE(PG8_SB(0, 1), cB + hstep, voffB); PG8_STAGE(PG8_SA(0, 1), cA + hstep, voffA);
    if (wr == 1) PG8_BAR;
    PG8_WAIT_V(4); PG8_BAR;
    PG8_STAGE(PG8_SB(1, 0), cB + kstep, voffB); PG8_STAGE(PG8_SA(1, 0), cA + kstep, voffA); PG8_STAGE(PG8_SB(1, 1), cB + hstep + kstep, voffB);
    PG8_WAIT_V(6); PG8_BAR;
    PG8_STAMP();
    for (;;) {
        const bool has_next = S.next(ui + 1, nxt);
        const char* nA = has_next ? (const char*)g.A + (size_t)nxt.pm * tstep : cA; const char* nB = has_next ? (const char*)g.Bt + (size_t)nxt.pn * tstep : cB;
        for (int t = 0; t < nt; t += 2) {
            const bool last = (t == nt - 2);
            const char* a1 = cA + (size_t)(t + 1) * kstep;
            const char* a2 = last ? nA : cA + (size_t)(t + 2) * kstep; const char* b2 = last ? nB : cB + (size_t)(t + 2) * kstep;
            const char* a3 = a2 + kstep; const char* b3 = b2 + kstep;
            if (last && has_next) S.a_ready(nxt);
            PG8_LDB(B0, 0, 0); PG8_SCHED; PG8_LDA(At, 0, 0); PG8_STAGE(PG8_SA(1, 1), a1 + hstep, voffA);
            PG8_WAIT_L(8); PG8_BAR; PG8_WAIT_L(0); PG8_MMA(0, 0, At, B0); PG8_BAR; PG8_SCHED;
            PG8_LDB(B1, 0, 1); PG8_STAGE(PG8_SB(0, 0), b2, voffB);
            PG8_BAR; PG8_WAIT_L(0); PG8_MMA(0, 1, At, B1); PG8_BAR;
            PG8_LDA(At, 0, 1); PG8_STAGE(PG8_SA(0, 0), a2, voffA);
            PG8_BAR; PG8_WAIT_L(0); PG8_MMA(1, 0, At, B0); PG8_BAR; PG8_SCHED;
            PG8_STAGE(PG8_SB(0, 1), b2 + hstep, voffB);
            PG8_WAIT_V(6); PG8_BAR; PG8_MMA(1, 1, At, B1); PG8_BAR;
            PG8_LDB(B0, 1, 0); PG8_SCHED; PG8_LDA(At, 1, 0); PG8_STAGE(PG8_SA(0, 1), a2 + hstep, voffA);
            PG8_WAIT_L(8); PG8_BAR; PG8_WAIT_L(0); PG8_MMA(0, 0, At, B0); PG8_BAR; PG8_SCHED;
            PG8_LDB(B1, 1, 1); PG8_STAGE(PG8_SB(1, 0), b3, voffB);
            PG8_BAR; PG8_WAIT_L(0); PG8_MMA(0, 1, At, B1); PG8_BAR;
            PG8_LDA(At, 1, 1); PG8_STAGE(PG8_SA(1, 0), a3, voffA);
            PG8_BAR; PG8_WAIT_L(0); PG8_MMA(1, 0, At, B0); PG8_BAR; PG8_SCHED;
            PG8_STAGE(PG8_SB(1, 1), b3 + hstep, voffB);
            PG8_WAIT_V(6); PG8_BAR; PG8_MMA(1, 1, At, B1); PG8_BAR;
        }
        PG8_STAMP();
        if constexpr (!Epi::AFTER_DRAIN) { E(acc, cur, wr, wc, fr, fq); S.done(cur); }
        PG8_STAMP();
        if (!has_next) break;
#pragma unroll
        for (int a = 0; a < 2; ++a)
#pragma unroll
            for (int b = 0; b < 2; ++b)
#pragma unroll
                for (int m = 0; m < 4; ++m)
#pragma unroll
                    for (int n = 0; n < 2; ++n) acc[a][b][m][n] = (f32x4){0.f, 0.f, 0.f, 0.f};
        cur = nxt; cA = nA; cB = nB; ++ui;
    }
    PG8_WAIT_V(0);
    if (wr == 0) PG8_BAR;
    PG8_BAR;
    if constexpr (Epi::AFTER_DRAIN) { E.fused(acc, cur, wr, wc, fr, fq, lds, wid, lane); S.done(cur); }
    PG8_STAMP();
    if (STAMP && wid == 0) { stamps[lane] = lane < nts ? (((unsigned long long)(unsigned)ts_hi << 32) | (unsigned)ts_lo) : 0ull;
        if (lane == 62) stamps[62] = rt_entry; if (lane == 63) stamps[63] = (unsigned long long)wall_clock64(); }
#undef PG8_STAMP
#undef PG8_SA
#undef PG8_SB
#undef PG8_STAGE
#undef PG8_LDA
#undef PG8_LDB
#undef PG8_MMA
#undef PG8_WAIT_V
#undef PG8_WAIT_L
#undef PG8_BAR
#undef PG8_SCHED
}
}
using namespace pg8;
namespace cg = cooperative_groups;
typedef float f32x16 __attribute__((ext_vector_type(16)));
typedef unsigned u32x2 __attribute__((ext_vector_type(2)));
#define LAS __attribute__((address_space(3)))
#define DI __device__ __forceinline__

constexpr int T = 49152, TP = 16384, RWC = 1856;
constexpr size_t MiB = (size_t)1 << 20;
constexpr size_t O_W1T = 0, O_W2T = 8 * MiB, O_WPGT = 16 * MiB, O_WPLET = 18 * MiB, O_GUPT = 18 * MiB + 512 * 1024, O_WUPF = O_GUPT + 128 * 1024,
    O_WUPB = O_WUPF + 64 * 1024, O_AUPT = O_WUPB + 64 * 1024, O_RSTD1 = 19 * MiB, O_BONUS = 19 * MiB + 256 * 1024, O_SSQ2 = 21 * MiB, O_SSQ3 = 24 * MiB,
    O_CTR = 27 * MiB, O_XB = 32 * MiB, O_ZRW = 128 * MiB, O_YA = 302 * MiB, O_YF = 350 * MiB, O_YBK = 398 * MiB, O_YB = 446 * MiB, O_G = 128 * MiB,
    O_MG = 350 * MiB, O_HID = 128 * MiB, O_G7 = 128 * MiB, O_PB = 224 * MiB, O_WINT = 496 * MiB, O_WGT = 503 * MiB, O_WAT = 507 * MiB, O_WBT = 508 * MiB,
    O_WOT = 509 * MiB, WS_NEED = 512 * MiB;
constexpr int LDS_BYTES = STAGE_BYTES;

DI float bflo(unsigned u) { return __uint_as_float(u << 16); }
DI float bfhi(unsigned u) { return __uint_as_float(u & 0xffff0000u); }
DI float sigm(float x) { return __builtin_amdgcn_rcpf(1.0f + __expf(-x)); }
DI u32x4 pack8(const float* f) { u32x4 w; w.x = cvt_pk_bf16(f[0], f[1]); w.y = cvt_pk_bf16(f[2], f[3]); w.z = cvt_pk_bf16(f[4], f[5]); w.w = cvt_pk_bf16(f[6], f[7]); return w; }
DI u32x4 pack8v(f32x4 a, f32x4 b) { u32x4 w; w.x = cvt_pk_bf16(a[0], a[1]); w.y = cvt_pk_bf16(a[2], a[3]); w.z = cvt_pk_bf16(b[0], b[1]); w.w = cvt_pk_bf16(b[2], b[3]); return w; }
DI u32x2 pack4v(f32x4 a) { u32x2 w; w.x = cvt_pk_bf16(a[0], a[1]); w.y = cvt_pk_bf16(a[2], a[3]); return w; }
DI void unpack8(u32x4 w, f32x4& a, f32x4& b) { a = (f32x4){bflo(w.x), bfhi(w.x), bflo(w.y), bfhi(w.y)}; b = (f32x4){bflo(w.z), bfhi(w.z), bflo(w.w), bfhi(w.w)}; }
DI f32x4 unpack4(u32x2 w) { return (f32x4){bflo(w.x), bfhi(w.x), bflo(w.y), bfhi(w.y)}; }
DI float dpp_xor1(float x) { return __int_as_float(__builtin_amdgcn_mov_dpp(__float_as_int(x), 0xB1, 0xF, 0xF, true)); }
DI float dpp_xor2(float x) { return __int_as_float(__builtin_amdgcn_mov_dpp(__float_as_int(x), 0x4E, 0xF, 0xF, true)); }
DI void wave_lds_fence() { asm volatile("s_waitcnt lgkmcnt(0)" ::: "memory"); __builtin_amdgcn_wave_barrier(); }
#define MFMA32(a, b, c) __builtin_amdgcn_mfma_f32_32x32x16_bf16((a), (b), (c), 0, 0, 0)
#define MFMA16(a, b, c) __builtin_amdgcn_mfma_f32_16x16x32_bf16((a), (b), (c), 0, 0, 0)

DI void conv8(const bf16_t* z, size_t rowoff, bool hp, bool hn, const float* cw, int col, float* out) {
    const u32x4 zz = (u32x4){0u, 0u, 0u, 0u};
    const u32x4 a = hp ? *(const u32x4*)(z + rowoff - RWC) : zz;
    const u32x4 b = *(const u32x4*)(z + rowoff);
    const u32x4 c = hn ? *(const u32x4*)(z + rowoff + RWC) : zz;
    const f32x4 w0a = *(const f32x4*)(cw + col), w0b = *(const f32x4*)(cw + col + 4);
    const f32x4 w1a = *(const f32x4*)(cw + RWC + col), w1b = *(const f32x4*)(cw + RWC + col + 4);
    const f32x4 w2a = *(const f32x4*)(cw + 2 * RWC + col), w2b = *(const f32x4*)(cw + 2 * RWC + col + 4);
    f32x4 a0, a1, b0, b1, c0, c1; unpack8(a, a0, a1); unpack8(b, b0, b1); unpack8(c, c0, c1);
    const f32x4 o0 = a0 * w0a + b0 * w1a + c0 * w2a, o1 = a1 * w0b + b1 * w1b + c1 * w2b;
#pragma unroll
    for (int j = 0; j < 4; ++j) { out[j] = o0[j]; out[4 + j] = o1[j]; }
}
DI f32x4 conv4(const bf16_t* z, size_t rowoff, bool hp, bool hn, const float* cw, int col) {
    const u32x2 zz = (u32x2){0u, 0u};
    const u32x2 a = hp ? *(const u32x2*)(z + rowoff - RWC) : zz;
    const u32x2 b = *(const u32x2*)(z + rowoff);
    const u32x2 c = hn ? *(const u32x2*)(z + rowoff + RWC) : zz;
    return unpack4(a) * *(const f32x4*)(cw + col) + unpack4(b) * *(const f32x4*)(cw + RWC + col) + unpack4(c) * *(const f32x4*)(cw + 2 * RWC + col);
}

struct EpiG1 {
    static constexpr bool PERM = true, AFTER_DRAIN = false;
    bf16_t *q, *k, *vT, *zrw; const float *rstd, *qg, *kg;
    __device__ __forceinline__ void operator()(const f32x4 (&acc)[2][2][4][2], const Unit& u, int wr, int wc, int fr, int fq) const {
        const int row0 = u.pm * BM + wr * 64 + fr;
        if (u.pn < 6) {
            const int kind = u.pn >> 1, head = 4 * (u.pn & 1) + wc;
            if (kind < 2) {
                bf16_t* dst = kind ? k : q; const float* gn = kind ? kg : qg;
                f32x4 g0[2][2];
#pragma unroll
                for (int bj = 0; bj < 2; ++bj)
#pragma unroll
                    for (int n = 0; n < 2; ++n) g0[bj][n] = *(const f32x4*)(gn + 32 * bj + 8 * fq + 4 * n);
#pragma unroll
                for (int ai = 0; ai < 2; ++ai)
#pragma unroll
                    for (int m = 0; m < 4; ++m) {
                        const int row = row0 + ai * HALF + m * 16; const float rs = rstd[row];
                        f32x4 v[2][2]; float ss = 0.f;
#pragma unroll
                        for (int bj = 0; bj < 2; ++bj)
#pragma unroll
                            for (int n = 0; n < 2; ++n) { v[bj][n] = acc[ai][bj][m][n] * rs; const f32x4 s = v[bj][n] * v[bj][n]; ss += (s[0] + s[1]) + (s[2] + s[3]); }
                        ss += __shfl_xor(ss, 16); ss += __shfl_xor(ss, 32);
                        const float sc = rsqrtf(ss * (1.0f / 64.0f) + 1e-6f);
#pragma unroll
                        for (int bj = 0; bj < 2; ++bj)
                            *(u32x4*)(dst + (size_t)row * 512 + head * 64 + 32 * bj + 8 * fq) = pack8v(v[bj][0] * sc * g0[bj][0], v[bj][1] * sc * g0[bj][1]);
                    }
            } else {
#pragma unroll
                for (int ai = 0; ai < 2; ++ai)
#pragma unroll
                    for (int m = 0; m < 4; ++m) {
                        const int row = row0 + ai * HALF + m * 16; const float rs = rstd[row];
#pragma unroll
                        for (int bj = 0; bj < 2; ++bj)
#pragma unroll
                            for (int n = 0; n < 2; ++n) {
                                const f32x4 v = acc[ai][bj][m][n] * rs; const unsigned p0 = cvt_pk_bf16(v[0], v[1]), p1 = cvt_pk_bf16(v[2], v[3]);
                                bf16_t* d = vT + (size_t)(head * 64 + 32 * bj + 8 * fq + 4 * n) * T + row;
                                d[0] = (bf16_t)(p0 & 0xffffu); d[T] = (bf16_t)(p0 >> 16); d[2 * (size_t)T] = (bf16_t)(p1 & 0xffffu); d[3 * (size_t)T] = (bf16_t)(p1 >> 16);
                            }
                    }
            }
        } else {
            const int col0 = (u.pn - 6) * BM + wc * 32 + 8 * fq;
#pragma unroll
            for (int ai = 0; ai < 2; ++ai)
#pragma unroll
                for (int m = 0; m < 4; ++m) {
                    const int row = row0 + ai * HALF + m * 16; const float rs = rstd[row];
#pragma unroll
                    for (int bj = 0; bj < 2; ++bj) { const int col = col0 + bj * HALF;
                        if (col < RWC) *(u32x4*)(zrw + (size_t)row * RWC + col) = pack8v(acc[ai][bj][m][0] * rs, acc[ai][bj][m][1] * rs); }
                }
        }
    }
};
template <int MODE> struct EpiB {
    static constexpr bool PERM = true, AFTER_DRAIN = false;
    bf16_t* O; int ld; const float* rs; const bf16_t* G;
    __device__ __forceinline__ void operator()(const f32x4 (&acc)[2][2][4][2], const Unit& u, int wr, int wc, int fr, int fq) const {
        const int row0 = u.pm * BM + wr * 64 + fr, col0 = u.pn * BM + wc * 32 + 8 * fq;
#pragma unroll
        for (int ai = 0; ai < 2; ++ai)
#pragma unroll
            for (int m = 0; m < 4; ++m) {
                const int row = row0 + ai * HALF + m * 16; float r = 1.f;
                if (MODE == 0) r = rs[row];
                if (MODE == 3) { const f32x4* p = (const f32x4*)(rs + (size_t)row * 16); const f32x4 s = (p[0] + p[1]) + (p[2] + p[3]); r = rsqrtf(((s[0] + s[1]) + (s[2] + s[3])) * (1.0f / 1024.0f) + 1e-6f); }
#pragma unroll
                for (int bj = 0; bj < 2; ++bj) {
                    const size_t off = (size_t)row * ld + col0 + bj * HALF;
                    f32x4 v0 = acc[ai][bj][m][0], v1 = acc[ai][bj][m][1];
                    if (MODE == 0) {
#pragma unroll
                        for (int j = 0; j < 4; ++j) { v0[j] = sigm(v0[j] * r); v1[j] = sigm(v1[j] * r); } }
                    if (MODE == 1 || MODE == 2) { f32x4 g0, g1; unpack8(*(const u32x4*)(G + off), g0, g1); v0 *= g0; v1 *= g1; }
                    if (MODE == 2) { f32x4 m0, m1; unpack8(*(const u32x4*)(O + off), m0, m1); v0 += m0; v1 += m1; }
                    if (MODE == 3) {
#pragma unroll
                        for (int j = 0; j < 4; ++j) { const float a = fmaxf(v0[j] * r, 0.f), b = fmaxf(v1[j] * r, 0.f); v0[j] = a * a; v1[j] = b * b; } }
                    *(u32x4*)(O + off) = pack8v(v0, v1);
                }
            }
    }
};
template <int MODE> struct EpiF {
    static constexpr bool PERM = false, AFTER_DRAIN = false;
    const float* resP; const float* resS; float* out; bf16_t* hb; float* ssq; const float* ssin;
    __device__ __forceinline__ void operator()(const f32x4 (&acc)[2][2][4][2], const Unit& u, int wr, int wc, int fr, int fq) const {
        const int row0 = u.pm * BM + wr * 64 + fr, col0 = u.pn * BM + wc * 32 + 4 * fq;
#pragma unroll
        for (int ai = 0; ai < 2; ++ai)
#pragma unroll
            for (int m = 0; m < 4; ++m) {
                const int row = row0 + ai * HALF + m * 16; float r = 1.f, ssl = 0.f;
                if (MODE == 1) { const f32x4* p = (const f32x4*)(ssin + (size_t)row * 16); const f32x4 s = (p[0] + p[1]) + (p[2] + p[3]); r = rsqrtf(((s[0] + s[1]) + (s[2] + s[3])) * (1.0f / 1024.0f) + 1e-6f); }
                const float* rp = (row < TP) ? resP + (size_t)row * 1024 : resS + (size_t)(row - TP) * 1024;
#pragma unroll
                for (int bj = 0; bj < 2; ++bj)
#pragma unroll
                    for (int n = 0; n < 2; ++n) {
                        const int col = col0 + bj * HALF + n * 16; const size_t off = (size_t)row * 1024 + col;
                        f32x4 v = acc[ai][bj][m][n];
                        if (MODE == 0) {
#if defined(PROBE1)
                            if (ssin != nullptr) v = (f32x4){0.f, 0.f, 0.f, 0.f};
#endif
                            v += *(const f32x4*)(rp + col); *(f32x4*)(out + off) = v; *(u32x2*)(hb + off) = pack4v(v); const f32x4 s = v * v; ssl += (s[0] + s[1]) + (s[2] + s[3]); }
                        if (MODE == 1) {
#pragma unroll
                            for (int j = 0; j < 4; ++j) v[j] = sigm(v[j] * r);
                            *(u32x2*)(hb + off) = pack4v(v); }
                        if (MODE == 2) { const f32x4 g = unpack4(*(const u32x2*)(hb + off)); *(f32x4*)(out + off) = *(const f32x4*)(out + off) + g * v; }
                    }
                if (MODE == 0) { ssl += __shfl_xor(ssl, 16); ssl += __shfl_xor(ssl, 32); if (fq == 0) ssq[(size_t)row * 16 + u.pn * 4 + wc] = ssl; }
            }
    }
};
DI void p0_transpose(LAS float* tl, const float* W, int ldw, int K, int Nrows, bf16_t* dst, const float* gs, int mode, int col0, int G, int b, int tid) {
    const int ntk = K / 64, ntn = Nrows / 64;
    for (int tile = b; tile < ntk * ntn; tile += G) {
        const int tk = tile % ntk, tn = tile / ntk;
#pragma unroll
        for (int i = 0; i < 2; ++i) {
            const int kk = (tid >> 4) + 32 * i, n = tn * 64 + (tid & 15) * 4; int col = col0 + n;
            if (mode == 1) { if (n < 1536) { const int pn = n >> 8, j = n & 255; col = 256 * pn + 64 * ((j >> 5) & 3) + 32 * (j >> 7) + (j & 31); } else if (n >= 3392) col = -1; }
            f32x4 v = (f32x4){0.f, 0.f, 0.f, 0.f};
            if (col >= 0) v = *(const f32x4*)(W + (size_t)(tk * 64 + kk) * ldw + col);
            if (gs) v *= gs[tk * 64 + kk];
#pragma unroll
            for (int j = 0; j < 4; ++j) tl[kk * 65 + (tid & 15) * 4 + j] = v[j];
        }
        __syncthreads();
        { const int n = tid >> 3, k8 = (tid & 7) * 8; float f[8];
#pragma unroll
          for (int j = 0; j < 8; ++j) f[j] = tl[(k8 + j) * 65 + n];
          *(u32x4*)(dst + (size_t)(tn * 64 + n) * K + tk * 64 + k8) = pack8(f); }
        __syncthreads();
    }
}

DI void na_item(int item, const bf16_t* q, const bf16_t* k, const bf16_t* vT, const float* relb, bf16_t* ya, int lane) {
    asm volatile("" : "+v"(lane));
    const int cb = item & 3, h = (item >> 2) & 7, pr = item >> 5;
    const int rows = pr < 256 ? 128 : 32;
    const int r = pr < 256 ? (pr & 127) : ((pr - 256) & 31);
    const int rs0 = min(max(r - 4, 0), rows - 8);
    const int prbase = pr - r + rs0;
    const int blk = min(max(cb * 16 - 8, 0), 32);
    const int l16 = lane & 15, g = lane >> 4;
    const bf16_t* qp = q + (size_t)(pr * 64 + cb * 16 + l16) * 512 + h * 64 + 8 * g;
    const bf16x8 qf0 = *(const bf16x8*)qp, qf1 = *(const bf16x8*)(qp + 32);
    f32x4 sc[8][2];
#pragma unroll
    for (int s = 0; s < 8; ++s)
#pragma unroll
        for (int u = 0; u < 2; ++u) {
            const int tok = (prbase + s) * 64 + blk + 8 * (l16 >> 2) + 4 * u + (l16 & 3);
            const bf16_t* kp = k + (size_t)tok * 512 + h * 64 + 8 * g;
            const bf16x8 kf0 = *(const bf16x8*)kp, kf1 = *(const bf16x8*)(kp + 32);
            f32x4 a = (f32x4){0.f, 0.f, 0.f, 0.f};
            a = MFMA16(kf0, qf0, a); a = MFMA16(kf1, qf1, a);
            sc[s][u] = a;
            if (u == 1 && (s & 1)) asm volatile("" ::: "memory");
        }
    const int qc = cb * 16 + l16, cs = min(max(qc - 8, 0), 48);
    const float* rb = relb + h * 465;
    float mx = -3.0e38f;
#pragma unroll
    for (int s = 0; s < 8; ++s) {
        const int dr = rs0 + s - r + 7;
#pragma unroll
        for (int u = 0; u < 2; ++u)
#pragma unroll
            for (int j = 0; j < 4; ++j) {
                const int kc = blk + 8 * g + 4 * u + j; const bool valid = (kc >= cs) && (kc < cs + 16);
                const int dc = min(max(kc - qc + 15, 0), 30);
                float v = sc[s][u][j] * 0.125f + rb[dr * 31 + dc];
                v = valid ? v : -1.0e30f; sc[s][u][j] = v; mx = fmaxf(mx, v);
            }
    }
    mx = fmaxf(mx, __shfl_xor(mx, 16)); mx = fmaxf(mx, __shfl_xor(mx, 32));
    float sum = 0.f;
#pragma unroll
    for (int s = 0; s < 8; ++s)
#pragma unroll
        for (int u = 0; u < 2; ++u)
#pragma unroll
            for (int j = 0; j < 4; ++j) { const float p = __expf(sc[s][u][j] - mx); sc[s][u][j] = p; sum += p; }
    sum += __shfl_xor(sum, 16); sum += __shfl_xor(sum, 32);
    const float inv = 1.0f / sum;
    f32x4 o[4];
#pragma unroll
    for (int dt = 0; dt < 4; ++dt) o[dt] = (f32x4){0.f, 0.f, 0.f, 0.f};
#pragma unroll
    for (int s = 0; s < 8; ++s) {
        const u32x4 pw = pack8v(sc[s][0] * inv, sc[s][1] * inv); const bf16x8 pa = __builtin_bit_cast(bf16x8, pw);
#pragma unroll
        for (int dt = 0; dt < 4; ++dt) {
            const bf16x8 vf = *(const bf16x8*)(vT + (size_t)(h * 64 + 16 * dt + l16) * T + (prbase + s) * 64 + blk + 8 * g);
            o[dt] = MFMA16(pa, vf, o[dt]);
        }
        if (s & 1) asm volatile("" ::: "memory");
    }
#pragma unroll
    for (int dt = 0; dt < 4; ++dt)
#pragma unroll
        for (int j = 0; j < 4; ++j) {
            const unsigned p = cvt_pk_bf16(o[dt][j], 0.f);
            ya[(size_t)(pr * 64 + cb * 16 + 4 * g + j) * 512 + h * 64 + 16 * dt + l16] = (bf16_t)(p & 0xffffu);
        }
}

struct ScanArgs { const bf16_t* zrw; const float* convw; const bf16_t *wupTf, *wupTb, *aupT; const float *w0f, *w0b, *a0, *k_k, *k_a, *r_k; float* bonus; bf16_t *yf, *ybk; };
DI void scan_item(int it, LAS float* L, LAS float* PK, const ScanArgs& A, int lane) {
    int tok0, Ls;
    if (it < 32) { tok0 = (it >> 4) * 8192; Ls = 8192; } else { it -= 32; tok0 = TP + (it >> 4) * 2048; Ls = 2048; }
    const int h = (it >> 1) & 7, dir = it & 1;
    LAS float *LW = L, *LKK = L + 2048, *LB = L + 4096, *LKT = L + 6144, *LR = L + 8192, *LV = L + 10240;
    const bf16_t* wupT = dir ? A.wupTb : A.wupTf; const float* w0 = dir ? A.w0b : A.w0f; bf16_t* yout = dir ? A.ybk : A.yf;
    const int dwcol = 1536 + 64 * dir;
#pragma unroll
    for (int i = 0; i < 16; ++i) *(LAS f32x4*)(PK + (i * 64 + lane) * 4) = (f32x4){0.f, 0.f, 0.f, 0.f};
    const int nch = Ls / 32;
    for (int ci = 0; ci < nch; ++ci) {
        const int c = dir ? nch - 1 - ci : ci; const int t0 = tok0 + c * 32;
        const float *cwp = A.convw, *w0p = w0, *a0p = A.a0, *kkp = A.k_k, *kap = A.k_a, *rkp = A.r_k; const bf16_t *wup = wupT, *aup = A.aupT;
        asm volatile("" : "+s"(cwp), "+s"(w0p), "+s"(a0p), "+s"(kkp), "+s"(kap), "+s"(rkp), "+s"(wup), "+s"(aup));
        int ln = lane; asm volatile("" : "+v"(ln));
        {
            const int tk = ln & 31, hh = ln >> 5; const int t = t0 + tk; const int pos = t - tok0; const bool hp = pos > 0, hn = pos < Ls - 1;
            f32x16 acc[2][2];
#pragma unroll
            for (int mtx = 0; mtx < 2; ++mtx)
#pragma unroll
                for (int nt = 0; nt < 2; ++nt)
#pragma unroll
                    for (int i = 0; i < 16; ++i) acc[mtx][nt][i] = 0.f;
#pragma unroll
            for (int mtx = 0; mtx < 2; ++mtx)
#pragma unroll
                for (int ks = 0; ks < 4; ++ks) {
                    const int col = (mtx ? 1664 : dwcol) + 16 * ks + 8 * hh; float x[8];
                    conv8(A.zrw, (size_t)t * RWC + col, hp, hn, cwp, col, x);
                    if (mtx == 0) {
#pragma unroll
                        for (int j = 0; j < 8; ++j) x[j] = 1.0f - 2.0f * __builtin_amdgcn_rcpf(__expf(2.0f * x[j]) + 1.0f); }
                    const u32x4 pw = pack8(x); const bf16x8 bfrag = __builtin_bit_cast(bf16x8, pw);
                    const bf16_t* WT = mtx ? aup : wup;
#pragma unroll
                    for (int nt = 0; nt < 2; ++nt) {
                        const bf16x8 afrag = *(const bf16x8*)(WT + (size_t)(h * 64 + 32 * nt + tk) * 64 + 16 * ks + 8 * hh);
                        acc[mtx][nt] = MFMA32(afrag, bfrag, acc[mtx][nt]);
                    }
                }
#pragma unroll
            for (int mtx = 0; mtx < 2; ++mtx)
#pragma unroll
                for (int nt = 0; nt < 2; ++nt)
#pragma unroll
                    for (int gi = 0; gi < 4; ++gi) {
                        const int cc = 32 * nt + 8 * gi + 4 * hh; const f32x4 bias = *(const f32x4*)((mtx ? a0p : w0p) + h * 64 + cc); f32x4 o;
#pragma unroll
                        for (int j = 0; j < 4; ++j) { const float sg = sigm(bias[j] + acc[mtx][nt][4 * gi + j]); o[j] = mtx ? sg : __expf(-0.606531f * sg); }
                        *(LAS f32x4*)((mtx ? LB : LW) + tk * 64 + cc) = o;
                    }
        }
        wave_lds_fence();
        {
            const int tk = ln >> 1, half = ln & 1; const int t = t0 + tk; const int pos = t - tok0; const bool hp = pos > 0, hn = pos < Ls - 1;
            float n2 = 0.f, bon = 0.f;
#pragma unroll
            for (int cb = 0; cb < 4; ++cb) {
                const int c0 = 32 * half + 8 * cb, hc = h * 64 + c0; float rc[8], kc8[8], vc[8];
                conv8(A.zrw, (size_t)t * RWC + hc, hp, hn, cwp, hc, rc);
                asm volatile("" ::: "memory");
                conv8(A.zrw, (size_t)t * RWC + 512 + hc, hp, hn, cwp, 512 + hc, kc8);
                asm volatile("" ::: "memory");
                conv8(A.zrw, (size_t)t * RWC + 1024 + hc, hp, hn, cwp, 1024 + hc, vc);
                const f32x4 a_lo = *(const LAS f32x4*)(LB + tk * 64 + c0), a_hi = *(const LAS f32x4*)(LB + tk * 64 + c0 + 4);
                const f32x4 kk_lo = *(const f32x4*)(kkp + hc), kk_hi = *(const f32x4*)(kkp + hc + 4);
                const f32x4 ka_lo = *(const f32x4*)(kap + hc), ka_hi = *(const f32x4*)(kap + hc + 4);
                const f32x4 rk_lo = *(const f32x4*)(rkp + hc), rk_hi = *(const f32x4*)(rkp + hc + 4);
                f32x4 kr[2], kt[2];
#pragma unroll
                for (int j = 0; j < 8; ++j) {
                    const float a = j < 4 ? a_lo[j & 3] : a_hi[j & 3], kkw = j < 4 ? kk_lo[j & 3] : kk_hi[j & 3], kaw = j < 4 ? ka_lo[j & 3] : ka_hi[j & 3], rkw = j < 4 ? rk_lo[j & 3] : rk_hi[j & 3];
                    const float kraw = kc8[j] * kkw; n2 += kraw * kraw;
                    const float ktv = kc8[j] * (1.0f + (a - 1.0f) * kaw); bon += rc[j] * ktv * rkw;
                    kr[j >> 2][j & 3] = kraw; kt[j >> 2][j & 3] = ktv;
                }
                const int o = tk * 64 + c0;
                *(LAS f32x4*)(LR + o) = (f32x4){rc[0], rc[1], rc[2], rc[3]}; *(LAS f32x4*)(LR + o + 4) = (f32x4){rc[4], rc[5], rc[6], rc[7]};
                *(LAS f32x4*)(LV + o) = (f32x4){vc[0], vc[1], vc[2], vc[3]}; *(LAS f32x4*)(LV + o + 4) = (f32x4){vc[4], vc[5], vc[6], vc[7]};
                *(LAS f32x4*)(LKT + o) = kt[0]; *(LAS f32x4*)(LKT + o + 4) = kt[1];
                *(LAS f32x4*)(LKK + o) = kr[0]; *(LAS f32x4*)(LKK + o + 4) = kr[1];
                asm volatile("" ::: "memory");
            }
            n2 += dpp_xor1(n2); bon += dpp_xor1(bon);
            const float inv = 1.0f / fmaxf(sqrtf(n2), 1e-12f);
#pragma unroll
            for (int cb = 0; cb < 8; ++cb) {
                const int o = tk * 64 + 32 * half + 4 * cb;
                const f32x4 kk = *(const LAS f32x4*)(LKK + o) * inv, a = *(const LAS f32x4*)(LB + o);
                *(LAS f32x4*)(LKK + o) = kk; *(LAS f32x4*)(LB + o) = kk * a;
            }
            if (dir == 0 && half == 0) A.bonus[(size_t)t * 8 + h] = bon;
        }
        wave_lds_fence();
        {
            const int kc = ln & 3, rg = ln >> 2;
            f32x2 S[4][8];
#pragma unroll
            for (int r = 0; r < 4; ++r)
#pragma unroll
                for (int i = 0; i < 4; ++i) { const f32x4 x = *(const LAS f32x4*)(PK + ((r * 4 + i) * 64 + ln) * 4); S[r][2 * i] = (f32x2){x[0], x[1]}; S[r][2 * i + 1] = (f32x2){x[2], x[3]}; }
            for (int st = 0; st < 32; ++st) {
                const int tt = dir ? 31 - st : st; const int base = tt * 64 + 16 * kc;
                f32x2 kkv[8], wv[8], bv[8], ktv[8], rv[8];
#pragma unroll
                for (int q4 = 0; q4 < 4; ++q4) {
                    f32x4 x;
                    x = *(const LAS f32x4*)(LKK + base + 4 * q4); kkv[2 * q4] = (f32x2){x[0], x[1]}; kkv[2 * q4 + 1] = (f32x2){x[2], x[3]};
                    x = *(const LAS f32x4*)(LW + base + 4 * q4);  wv[2 * q4] = (f32x2){x[0], x[1]};  wv[2 * q4 + 1] = (f32x2){x[2], x[3]};
                    x = *(const LAS f32x4*)(LB + base + 4 * q4);  bv[2 * q4] = (f32x2){x[0], x[1]};  bv[2 * q4 + 1] = (f32x2){x[2], x[3]};
                    x = *(const LAS f32x4*)(LKT + base + 4 * q4); ktv[2 * q4] = (f32x2){x[0], x[1]}; ktv[2 * q4 + 1] = (f32x2){x[2], x[3]};
                    x = *(const LAS f32x4*)(LR + base + 4 * q4);  rv[2 * q4] = (f32x2){x[0], x[1]};  rv[2 * q4 + 1] = (f32x2){x[2], x[3]};
                }
                const f32x4 vv = *(const LAS f32x4*)(LV + tt * 64 + 4 * rg);
                float sa[4], y[4];
#pragma unroll
                for (int r = 0; r < 4; ++r) {
                    f32x2 s0 = S[r][0] * kkv[0], s1 = S[r][1] * kkv[1];
#pragma unroll
                    for (int i = 2; i < 8; i += 2) { s0 += S[r][i] * kkv[i]; s1 += S[r][i + 1] * kkv[i + 1]; }
                    s0 += s1; float s = s0.x + s0.y; s += dpp_xor1(s); s += dpp_xor2(s); sa[r] = -s;
                }
#pragma unroll
                for (int r = 0; r < 4; ++r) {
                    const f32x2 sar = (f32x2){sa[r], sa[r]}, vr = (f32x2){vv[r], vv[r]};
                    f32x2 y0 = (f32x2){0.f, 0.f}, y1 = (f32x2){0.f, 0.f};
#pragma unroll
                    for (int i = 0; i < 8; i += 2) {
                        S[r][i] = S[r][i] * wv[i] + sar * bv[i] + vr * ktv[i]; y0 += S[r][i] * rv[i];
                        S[r][i + 1] = S[r][i + 1] * wv[i + 1] + sar * bv[i + 1] + vr * ktv[i + 1]; y1 += S[r][i + 1] * rv[i + 1];
                    }
                    y0 += y1; float s = y0.x + y0.y; s += dpp_xor1(s); s += dpp_xor2(s); y[r] = s;
                }
                if (kc == 0) { u32x2 w; w.x = cvt_pk_bf16(y[0], y[1]); w.y = cvt_pk_bf16(y[2], y[3]); *(u32x2*)(yout + (size_t)(t0 + tt) * 512 + h * 64 + 4 * rg) = w; }
            }
#pragma unroll
            for (int r = 0; r < 4; ++r)
#pragma unroll
                for (int i = 0; i < 4; ++i) *(LAS f32x4*)(PK + ((r * 4 + i) * 64 + ln) * 4) = (f32x4){S[r][2 * i].x, S[r][2 * i].y, S[r][2 * i + 1].x, S[r][2 * i + 1].y};
        }
        wave_lds_fence();
    }
}

DI void post_item(int item, const bf16_t* zrw, const float* convw, const bf16_t* gupT, const bf16_t* yf, const bf16_t* ybk, const float* bonus, const float* lnw, const float* lnb, bf16_t* yb, int lane) {
    asm volatile("" : "+v"(lane));
    const int h = item & 7, tile = item >> 3, tk = lane & 31, hh = lane >> 5; const int t = tile * 32 + tk;
    const int pos = t < TP ? (t & 8191) : (t & 2047), Ls = t < TP ? 8192 : 2048; const bool hp = pos > 0, hn = pos < Ls - 1;
    f32x16 acc[2];
#pragma unroll
    for (int mt = 0; mt < 2; ++mt)
#pragma unroll
        for (int i = 0; i < 16; ++i) acc[mt][i] = 0.f;
#pragma unroll
    for (int ks = 0; ks < 8; ++ks) {
        const int col = 1728 + 16 * ks + 8 * hh; float x[8];
        conv8(zrw, (size_t)t * RWC + col, hp, hn, convw, col, x);
#pragma unroll
        for (int j = 0; j < 8; ++j) x[j] = sigm(x[j]);
        const u32x4 pw = pack8(x); const bf16x8 bfrag = __builtin_bit_cast(bf16x8, pw);
#pragma unroll
        for (int mt = 0; mt < 2; ++mt) {
            const bf16x8 afrag = *(const bf16x8*)(gupT + (size_t)(h * 64 + 32 * mt + tk) * 128 + 16 * ks + 8 * hh);
            acc[mt] = MFMA32(afrag, bfrag, acc[mt]);
        }
    }
    f32x4 y[2][4]; float sum = 0.f;
#pragma unroll
    for (int mt = 0; mt < 2; ++mt)
#pragma unroll
        for (int gi = 0; gi < 4; ++gi) {
            const size_t off = (size_t)t * 512 + h * 64 + 32 * mt + 8 * gi + 4 * hh;
            y[mt][gi] = unpack4(*(const u32x2*)(yf + off)) + unpack4(*(const u32x2*)(ybk + off));
            sum += (y[mt][gi][0] + y[mt][gi][1]) + (y[mt][gi][2] + y[mt][gi][3]);
        }
    sum += __shfl_xor(sum, 32); const float mu = sum * (1.0f / 64.0f); float qv = 0.f;
#pragma unroll
    for (int mt = 0; mt < 2; ++mt)
#pragma unroll
        for (int gi = 0; gi < 4; ++gi) { y[mt][gi] -= mu; const f32x4 s = y[mt][gi] * y[mt][gi]; qv += (s[0] + s[1]) + (s[2] + s[3]); }
    qv += __shfl_xor(qv, 32); const float rs = rsqrtf(qv * (1.0f / 64.0f) + 64e-5f);
    const float bn = bonus[(size_t)t * 8 + h];
#pragma unroll
    for (int mt = 0; mt < 2; ++mt)
#pragma unroll
        for (int gi = 0; gi < 4; ++gi) {
            const int hc = h * 64 + 32 * mt + 8 * gi + 4 * hh;
            const f32x4 v4 = conv4(zrw, (size_t)t * RWC + 1024 + hc, hp, hn, convw, 1024 + hc);
            const f32x4 lw = *(const f32x4*)(lnw + hc), lb = *(const f32x4*)(lnb + hc);
            f32x4 g4;
#pragma unroll
            for (int j = 0; j < 4; ++j) g4[j] = acc[mt][4 * gi + j];
            const f32x4 o = (y[mt][gi] * rs * lw + lb + v4 * bn) * g4;
            *(u32x2*)(yb + (size_t)t * 512 + hc) = pack4v(o);
        }
}
struct Params { const float* in[31]; float* out; unsigned char* ws; int ph_lo, ph_hi; };
constexpr int NPH = 10;
__global__ void __launch_bounds__(512) mega(Params P) {
    extern __shared__ __attribute__((aligned(16))) unsigned char lds_raw[];
    PG8_LAS unsigned char* lds = (PG8_LAS unsigned char*)lds_raw;
    cg::grid_group grid = cg::this_grid();
    const int wid = __builtin_amdgcn_readfirstlane(threadIdx.x >> 6), b = blockIdx.x, G = gridDim.x;
    unsigned char* ws = P.ws;
    bf16_t *W1T = (bf16_t*)(ws + O_W1T), *W2T = (bf16_t*)(ws + O_W2T), *WpgT = (bf16_t*)(ws + O_WPGT), *WpleT = (bf16_t*)(ws + O_WPLET), *gupT = (bf16_t*)(ws + O_GUPT),
           *wupTf = (bf16_t*)(ws + O_WUPF), *wupTb = (bf16_t*)(ws + O_WUPB), *aupT = (bf16_t*)(ws + O_AUPT), *xb = (bf16_t*)(ws + O_XB), *zrw = (bf16_t*)(ws + O_ZRW),
           *ya = (bf16_t*)(ws + O_YA), *yf = (bf16_t*)(ws + O_YF), *ybk = (bf16_t*)(ws + O_YBK), *yb = (bf16_t*)(ws + O_YB), *Gb = (bf16_t*)(ws + O_G), *MG = (bf16_t*)(ws + O_MG),
           *hid = (bf16_t*)(ws + O_HID), *G7 = (bf16_t*)(ws + O_G7), *pb = (bf16_t*)(ws + O_PB), *WinT = (bf16_t*)(ws + O_WINT), *WgT = (bf16_t*)(ws + O_WGT),
           *WaT = (bf16_t*)(ws + O_WAT), *WbT = (bf16_t*)(ws + O_WBT), *WoT = (bf16_t*)(ws + O_WOT);
    float *rstd1 = (float*)(ws + O_RSTD1), *bonus = (float*)(ws + O_BONUS), *ssq2 = (float*)(ws + O_SSQ2), *ssq3 = (float*)(ws + O_SSQ3);
    unsigned* ctr = (unsigned*)(ws + O_CTR);
    bf16_t *qb = (bf16_t*)P.out, *kb = qb + (size_t)T * 512, *vT = kb + (size_t)T * 512;
    const int lo = P.ph_lo, hi = P.ph_hi;
#define IN(k) (lo <= (k) && (k) < hi)
#define GET_TID() int lane; asm volatile("v_mbcnt_lo_u32_b32 %0, -1, 0\n\tv_mbcnt_hi_u32_b32 %0, -1, %0" : "=v"(lane)); const int tid = wid * 64 + lane; (void)tid
#define SEAM(k) do { if (IN(k) && IN((k) + 1)) grid.sync(); } while (0)

    if (IN(0)) {
        GET_TID();
        LAS float* tl = (LAS float*)lds;
        p0_transpose(tl, P.in[5], 5440, 1024, 3584, WinT, P.in[4], 1, 0, G, b, tid);
        p0_transpose(tl, P.in[5], 5440, 1024, 2048, WgT, P.in[4], 0, 3392, G, b, tid);
        p0_transpose(tl, P.in[22], 1024, 512, 1024, WaT, nullptr, 0, 0, G, b, tid);
        p0_transpose(tl, P.in[23], 1024, 512, 1024, WbT, nullptr, 0, 0, G, b, tid);
        p0_transpose(tl, P.in[24], 1024, 1024, 1024, WoT, nullptr, 0, 0, G, b, tid);
        p0_transpose(tl, P.in[26], 4096, 1024, 4096, W1T, P.in[25], 0, 0, G, b, tid);
        p0_transpose(tl, P.in[27], 1024, 4096, 1024, W2T, nullptr, 0, 0, G, b, tid);
        p0_transpose(tl, P.in[30], 1024, 1024, 1024, WpgT, P.in[29], 0, 0, G, b, tid);
        p0_transpose(tl, P.in[28], 1024, 256, 1024, WpleT, nullptr, 0, 0, G, b, tid);
        p0_transpose(tl, P.in[16], 512, 128, 512, gupT, nullptr, 0, 0, G, b, tid);
        p0_transpose(tl, P.in[11], 512, 64, 512, wupTf, nullptr, 0, 0, G, b, tid);
        p0_transpose(tl, P.in[13], 512, 64, 512, wupTb, nullptr, 0, 0, G, b, tid);
        p0_transpose(tl, P.in[15], 512, 64, 512, aupT, nullptr, 0, 0, G, b, tid);
        for (int row = b * 8 + wid; row < T; row += G * 8) {
            const float* xr = row < TP ? P.in[0] + (size_t)row * 1024 : P.in[1] + (size_t)(row - TP) * 1024;
            f32x4 v[4]; float ss = 0.f;
#pragma unroll
            for (int j = 0; j < 4; ++j) { v[j] = *(const f32x4*)(xr + j * 256 + lane * 4); const f32x4 s = v[j] * v[j]; ss += (s[0] + s[1]) + (s[2] + s[3]); }
#pragma unroll
            for (int o = 32; o >= 1; o >>= 1) ss += __shfl_xor(ss, o);
#pragma unroll
            for (int j = 0; j < 4; ++j) *(u32x2*)(xb + (size_t)row * 1024 + j * 256 + lane * 4) = pack4v(v[j]);
            if (lane == 0) rstd1[row] = rsqrtf(ss * (1.0f / 1024.0f) + 1e-6f);
        }
        if (b == 0 && tid == 0) ctr[0] = 0u;
    }
    SEAM(0);
    if (IN(1)) {
        GET_TID();
        Gemm g{xb, WinT, T, 3584, 1024}; StaticOrder S; S.init(T, 3584, G, b);
        EpiG1 E{qb, kb, vT, zrw, rstd1, P.in[7], P.in[8]};
        gemm_phase<EpiG1, StaticOrder>(lds, g, S, E, nullptr, tid);
    }
    SEAM(1);
    if (IN(2)) {
        GET_TID();
        const int slot = wid * G + b;
        if (wid < 2 && slot < 288) {
            ScanArgs SA{zrw, P.in[6], wupTf, wupTb, aupT, P.in[10], P.in[12], P.in[14], P.in[17], P.in[18], P.in[19], bonus, yf, ybk};
            scan_item(slot, (LAS float*)lds + wid * 12288, (LAS float*)lds + 24576 + wid * 4096, SA, lane);
        }
        for (;;) {
            unsigned idx = 0; if (lane == 0) idx = atomicAdd(ctr, 1u);
            idx = __builtin_amdgcn_readfirstlane(idx);
            if (idx >= 24576u) break;
            na_item((int)idx, qb, kb, vT, P.in[9], ya, lane);
        }
    }
    SEAM(2);
    if (IN(3)) {
        GET_TID();
        for (int item = b * 8 + wid; item < 12288; item += G * 8) post_item(item, zrw, P.in[6], gupT, yf, ybk, bonus, P.in[20], P.in[21], yb, lane);
    }
    SEAM(3);
    if (IN(4)) {
        GET_TID();
        StaticOrder S; S.init(T, 1024, G, b);
        { Gemm g{xb, WgT, T, 1024, 1024}; EpiB<0> E{Gb, 1024, rstd1, nullptr}; gemm_phase<EpiB<0>, StaticOrder>(lds, g, S, E, nullptr, tid); }
        { Gemm g{ya, WaT, T, 1024, 512}; EpiB<1> E{MG, 1024, nullptr, Gb}; gemm_phase<EpiB<1>, StaticOrder>(lds, g, S, E, nullptr, tid); }
        { Gemm g{xb, WgT + (size_t)1024 * 1024, T, 1024, 1024}; EpiB<0> E{Gb, 1024, rstd1, nullptr}; gemm_phase<EpiB<0>, StaticOrder>(lds, g, S, E, nullptr, tid); }
        { Gemm g{yb, WbT, T, 1024, 512}; EpiB<2> E{MG, 1024, nullptr, Gb}; gemm_phase<EpiB<2>, StaticOrder>(lds, g, S, E, nullptr, tid); }
    }
    SEAM(4);
    if (IN(5)) {
        GET_TID();
        Gemm g{MG, WoT, T, 1024, 1024}; StaticOrder S; S.init(T, 1024, G, b);
#if defined(PROBE4)
        EpiF<0> E{P.in[0], P.in[1], P.out, xb, ssq3, ssq2};
#elif defined(PROBE1)
        EpiF<0> E{P.in[0], P.in[1], P.out, xb, ssq2, ssq2};
#else
        EpiF<0> E{P.in[0], P.in[1], P.out, xb, ssq2, nullptr};
#endif
        gemm_phase<EpiF<0>, StaticOrder>(lds, g, S, E, nullptr, tid);
    }
    SEAM(5);
#if defined(PROBE4)
    if (false) {
#else
    if (IN(6)) {
#endif
        GET_TID();
        Gemm g{xb, W1T, T, 4096, 1024}; StaticOrder S; S.init(T, 4096, G, b);
        EpiB<3> E{hid, 4096, ssq2, nullptr};
        gemm_phase<EpiB<3>, StaticOrder>(lds, g, S, E, nullptr, tid);
    }
    SEAM(6);
#if defined(PROBE4)
    if (false) {
#else
    if (IN(7)) {
#endif
        GET_TID();
        Gemm g{hid, W2T, T, 1024, 4096}; StaticOrder S; S.init(T, 1024, G, b);
        EpiF<0> E{P.out, P.out + (size_t)TP * 1024, P.out, xb, ssq3, nullptr};
        gemm_phase<EpiF<0>, StaticOrder>(lds, g, S, E, nullptr, tid);
    }
    SEAM(7);
    if (IN(8)) {
        GET_TID();
        Gemm g{xb, WpgT, T, 1024, 1024}; StaticOrder S; S.init(T, 1024, G, b);
        EpiF<1> E{nullptr, nullptr, nullptr, G7, nullptr, ssq3};
        gemm_phase<EpiF<1>, StaticOrder>(lds, g, S, E, nullptr, tid);
        for (int i = b * 512 + tid; i < T * 32; i += G * 512) {
            const int row = i >> 5, c8 = (i & 31) * 8;
            const float* src = row < TP ? P.in[2] + (size_t)row * 256 + c8 : P.in[3] + (size_t)(row - TP) * 256 + c8;
            *(u32x4*)(pb + (size_t)row * 256 + c8) = pack8v(*(const f32x4*)src, *(const f32x4*)(src + 4));
        }
    }
    SEAM(8);
#if defined(PROBE2)
    if (false) {
#else
    if (IN(9)) {
#endif
        GET_TID();
#if defined(PROBE3)
        for (int idx = b * 512 + tid; idx < T * 256; idx += G * 512) {
            const int row = idx >> 8, c4 = (idx & 255) * 4; float s[4] = {0.f, 0.f, 0.f, 0.f};
            for (int k8 = 0; k8 < 32; ++k8) {
                f32x4 a0, a1; unpack8(*(const u32x4*)(pb + (size_t)row * 256 + k8 * 8), a0, a1);
#pragma unroll
                for (int j = 0; j < 4; ++j) { f32x4 w0, w1; unpack8(*(const u32x4*)(WpleT + (size_t)(c4 + j) * 256 + k8 * 8), w0, w1); const f32x4 m = a0 * w0 + a1 * w1; s[j] += (m[0] + m[1]) + (m[2] + m[3]); }
            }
#if defined(PROBE5)
            const f32x4 g = (f32x4){1.f, 1.f, 1.f, 1.f};
#else
            const f32x4 g = unpack4(*(const u32x2*)(G7 + (size_t)row * 1024 + c4));
#endif
            float* o = P.out + (size_t)row * 1024 + c4;
#pragma unroll
#if defined(PROBE6)
            for (int j = 0; j < 4; ++j) o[j] += g[j];
#else
            for (int j = 0; j < 4; ++j) o[j] += g[j] * s[j];
#endif
        }
#else
        Gemm g{pb, WpleT, T, 1024, 256}; StaticOrder S; S.init(T, 1024, G, b);
        EpiF<2> E{nullptr, nullptr, P.out, G7, nullptr, nullptr};
        gemm_phase<EpiF<2>, StaticOrder>(lds, g, S, E, nullptr, tid);
#endif
    }
#undef IN
#undef SEAM
}

extern "C" void kernel_launch(void* const* d_in, const int* in_sizes, int n_in, void* d_out, int out_size, void* d_ws, size_t ws_size, hipStream_t stream) {
    static int grid_blocks = 0;
    if (grid_blocks == 0) {
        if (n_in != 31 || out_size != T * 1024 || ws_size < WS_NEED) { fprintf(stderr, "kernel_launch: unexpected shapes (n_in %d out %d ws %zu)\n", n_in, out_size, ws_size); grid_blocks = -1; return; }
        int dev = 0, cus = 0, per_cu = 0;
        hipGetDevice(&dev); hipDeviceGetAttribute(&cus, hipDeviceAttributeMultiprocessorCount, dev);
        if (hipFuncSetAttribute((const void*)mega, hipFuncAttributeMaxDynamicSharedMemorySize, LDS_BYTES) != hipSuccess) { fprintf(stderr, "kernel_launch: hipFuncSetAttribute failed\n"); grid_blocks = -1; return; }
        hipOccupancyMaxActiveBlocksPerMultiprocessor(&per_cu, (const void*)mega, 512, LDS_BYTES);
        if (per_cu < 1) { fprintf(stderr, "kernel_launch: occupancy query says %d blocks per CU\n", per_cu); grid_blocks = -1; return; }
        grid_blocks = cus;
    }
    if (grid_blocks < 0) return;
    Params p{};
    for (int i = 0; i < 31; ++i) p.in[i] = (const float*)d_in[i];
    p.out = (float*)d_out; p.ws = (unsigned char*)d_ws;
#if defined(SPLIT_LAUNCH)
    for (int ph = 0; ph < NPH; ++ph) { p.ph_lo = ph; p.ph_hi = ph + 1; hipLaunchKernelGGL(mega, dim3(grid_blocks), dim3(512), LDS_BYTES, stream, p); }
#else
    p.ph_lo = 0; p.ph_hi = NPH;
    void* args[] = {&p};
    hipError_t e = hipLaunchCooperativeKernel((const void*)mega, dim3(grid_blocks), dim3(512), args, LDS_BYTES, stream);
    if (e != hipSuccess) fprintf(stderr, "cooperative launch failed: %s (grid %d)\n", hipGetErrorString(e), grid_blocks);
#endif
}
```

```cpp
#include <hip/hip_runtime.h>
#include <hip/hip_cooperative_groups.h>
#include <cstdio>
namespace pg8 {
#define PG8_LAS __attribute__((address_space(3)))
typedef unsigned short bf16_t;
typedef short bf16x8 __attribute__((ext_vector_type(8)));
typedef float f32x4 __attribute__((ext_vector_type(4)));
typedef unsigned u32x4 __attribute__((ext_vector_type(4)));
constexpr int BM = 256, BK = 64, HALF = 128, HTB = HALF * BK * 2  , STAGE_BYTES = 8 * HTB, NXCD = 8, WGM = 8;

__host__ __device__ __forceinline__ int lds_byte(int r, int c) { const int st = (r >> 4) * 2 + (c >> 5), rr = r & 15, cc = c & 31, ob = rr * 64 + cc * 2; return st * 1024 + (ob ^ (((ob >> 9) & 1) << 5)); }
__host__ __device__ __forceinline__ void stage_rc(int b, int& R, int& C) { const int st = b / 1024, sb = b % 1024, swz = sb ^ (((sb >> 9) & 1) << 5); R = (st >> 1) * 16 + swz / 64; C = (st & 1) * 32 + (swz % 64) / 2; }
__host__ __device__ __forceinline__ int perm32(int rho) { const int n = rho >> 4, i = rho & 15; return 8 * (i >> 2) + 4 * n + (i & 3); }

struct Unit { int pm, pn; };
struct Gemm { const bf16_t* A; const bf16_t* Bt; int M, N, K; };

struct StaticOrder {
    int nM, nN, nwg, G, c;
    __host__ __device__ void init(int M, int N, int G_, int c_) { nM = M / BM; nN = N / BM; nwg = nM * nN; G = G_; c = c_; }
    __host__ __device__ bool next(int i, Unit& u) const {
        const long L = (long)i * G + c; if (L >= nwg) return false;
        int wgid = (int)L; { const int q = nwg / NXCD, r = nwg % NXCD, xcd = wgid % NXCD, off = wgid / NXCD; wgid = (xcd < r ? xcd * (q + 1) : r * (q + 1) + (xcd - r) * q) + off; }
        const int nig = WGM * nN, gid = wgid / nig, fm = gid * WGM, gsz = (nM - fm) < WGM ? (nM - fm) : WGM;
        u.pm = fm + ((wgid % nig) % gsz); u.pn = (wgid % nig) / gsz; return true;
    }
    __device__ __forceinline__ void a_ready(const Unit&) const {}
    __device__ __forceinline__ void done(const Unit&) const {}
};
typedef __bf16 bf16x2v_t __attribute__((ext_vector_type(2)));
typedef float f32x2 __attribute__((ext_vector_type(2)));
__device__ __forceinline__ unsigned cvt_pk_bf16(float lo, float hi) { const f32x2 v = (f32x2){lo, hi}; const bf16x2v_t b = __builtin_convertvector(v, bf16x2v_t); return __builtin_bit_cast(unsigned, b); }
template <class Epi, class Sched, bool STAMP = false>
__device__ __forceinline__ void gemm_phase(PG8_LAS unsigned char* lds, const Gemm g, const Sched& S, const Epi& E, unsigned long long* stamps, const int tid) {
    const int wid = __builtin_amdgcn_readfirstlane(tid >> 6), lane = tid & 63, wr = wid >> 2, wc = wid & 3, fr = lane & 15, fq = lane >> 4;
    const int K = g.K, nt = K / BK;
    int ts_lo = 0, ts_hi = 0, nts = 0; const unsigned long long rt_entry = STAMP ? (unsigned long long)wall_clock64() : 0ull;
#define PG8_STAMP() do { if (STAMP && wid == 0 && nts < 64) { const unsigned long long _c = (unsigned long long)clock64(); \
        ts_lo = (lane == nts) ? (int)(unsigned)_c : ts_lo; ts_hi = (lane == nts) ? (int)(unsigned)(_c >> 32) : ts_hi; ++nts; } } while (0)
    PG8_STAMP();
    unsigned voffA[2], voffB[2];
#pragma unroll
    for (int i = 0; i < 2; ++i) { int R, C; stage_rc(tid * 16 + i * 8192, R, C); const int Rb = Epi::PERM ? ((R & ~31) + perm32(R & 31)) : R;
        voffA[i] = (unsigned)(R * K + C) * 2u; voffB[i] = (unsigned)(Rb * K + C) * 2u; }
    const size_t kstep = (size_t)(BK * 2);
    const size_t hstep = (size_t)HALF * K * 2;
    const size_t tstep = 2 * hstep;
    const unsigned ldsw = (unsigned)wid * 1024u;
    const int aoff = lds_byte(wr * 64 + fr, fq * 8), boff = lds_byte(wc * 32 + fr, fq * 8);
#define PG8_SA(b, h) (((b) * 2 + (h)) * HTB)
#define PG8_SB(b, h) ((4 + (b) * 2 + (h)) * HTB)
#define PG8_STAGE(bufoff, gbase, voff) do { _Pragma("unroll") for (int _i = 0; _i < 2; ++_i) \
        __builtin_amdgcn_global_load_lds((const unsigned*)((const char*)(gbase) + (voff)[_i]), (PG8_LAS unsigned*)(lds + (bufoff) + ldsw + _i * 8192), 16, 0, 0); } while (0)
#define PG8_LDA(dst, b, h) do { _Pragma("unroll") for (int m = 0; m < 4; ++m) _Pragma("unroll") for (int k = 0; k < 2; ++k) dst[m][k] = *(const PG8_LAS bf16x8*)(lds + PG8_SA(b, h) + aoff + m * 2048 + k * 1024); } while (0)
#define PG8_LDB(dst, b, h) do { _Pragma("unroll") for (int n = 0; n < 2; ++n) _Pragma("unroll") for (int k = 0; k < 2; ++k) dst[n][k] = *(const PG8_LAS bf16x8*)(lds + PG8_SB(b, h) + boff + n * 2048 + k * 1024); } while (0)
#define PG8_MMA(ai, bj, At, Bt) do { __builtin_amdgcn_s_setprio(1); _Pragma("unroll") for (int m = 0; m < 4; ++m) _Pragma("unroll") for (int n = 0; n < 2; ++n) _Pragma("unroll") for (int k = 0; k < 2; ++k) \
        acc[ai][bj][m][n] = __builtin_amdgcn_mfma_f32_16x16x32_bf16(Bt[n][k], At[m][k], acc[ai][bj][m][n], 0, 0, 0); __builtin_amdgcn_s_setprio(0); } while (0)
#define PG8_WAIT_V(n) asm volatile("s_waitcnt vmcnt(" #n ")" ::: "memory")
#define PG8_WAIT_L(n) asm volatile("s_waitcnt lgkmcnt(" #n ")" ::: "memory")
#define PG8_BAR __builtin_amdgcn_s_barrier()
#define PG8_SCHED __builtin_amdgcn_sched_barrier(0)
    Unit cur, nxt; int ui = 0;
    if (!S.next(0, cur)) return;
    f32x4 acc[2][2][4][2];
#pragma unroll
    for (int a = 0; a < 2; ++a)
#pragma unroll
        for (int b = 0; b < 2; ++b)
#pragma unroll
            for (int m = 0; m < 4; ++m)
#pragma unroll
                for (int n = 0; n < 2; ++n) acc[a][b][m][n] = (f32x4){0.f, 0.f, 0.f, 0.f};
    bf16x8 At[4][2], B0[2][2], B1[2][2];
    const char* cA = (const char*)g.A + (size_t)cur.pm * tstep; const char* cB = (const char*)g.Bt + (size_t)cur.pn * tstep;
    S.a_ready(cur);
    PG8_STAGE(PG8_SB(0, 0), cB, voffB); PG8_STAGE(PG8_SA(0, 0), cA, voffA); PG8_STAGE(PG8_SB(0, 1), cB + hstep, voffB); PG8_STAGE(PG8_SA(0, 1), cA + hstep, voffA);
    if (wr == 1) PG8_BAR;
    PG8_WAIT_V(4); PG8_BAR;
    PG8_STAGE(PG8_SB(1, 0), cB + kstep, voffB); PG8_STAGE(PG8_SA(1, 0), cA + kstep, voffA); PG8_STAGE(PG8_SB(1, 1), cB + hstep + kstep, voffB);
    PG8_WAIT_V(6); PG8_BAR;
    PG8_STAMP();
    for (;;) {
        const bool has_next = S.next(ui + 1, nxt);
        const char* nA = has_next ? (const char*)g.A + (size_t)nxt.pm * tstep : cA; const char* nB = has_next ? (const char*)g.Bt + (size_t)nxt.pn * tstep : cB;
        for (int t = 0; t < nt; t += 2) {
            const bool last = (t == nt - 2);
            const char* a1 = cA + (size_t)(t + 1) * kstep;
            const char* a2 = last ? nA : cA + (size_t)(t + 2) * kstep; const char* b2 = last ? nB : cB + (size_t)(t + 2) * kstep;
            const char* a3 = a2 + kstep; const char* b3 = b2 + kstep;
            if (last && has_next) S.a_ready(nxt);
            PG8_LDB(B0, 0, 0); PG8_SCHED; PG8_LDA(At, 0, 0); PG8_STAGE(PG8_SA(1, 1), a1 + hstep, voffA);
            PG8_WAIT_L(8); PG8_BAR; PG8_WAIT_L(0); PG8_MMA(0, 0, At, B0); PG8_BAR; PG8_SCHED;
            PG8_LDB(B1, 0, 1); PG8_STAGE(PG8_SB(0, 0), b2, voffB);
            PG8_BAR; PG8_WAIT_L(0); PG8_MMA(0, 1, At, B1); PG8_BAR;
            PG8_LDA(At, 0, 1); PG8_STAGE(PG8_SA(0, 0), a2, voffA);
            PG8_BAR; PG8_WAIT_L(0); PG8_MMA(1, 0, At, B0); PG8_BAR; PG8_SCHED;
            PG8_STAGE(PG8_SB(0, 1), b2 + hstep, voffB);
            PG8_WAIT_V(6); PG8_BAR; PG8_MMA(1, 1, At, B1); PG8_BAR;
            PG8_LDB(B0, 1, 0); PG8_SCHED; PG8_LDA(At, 1, 0); PG8_STAGE(PG8_SA(0, 1), a2 + hstep, voffA);
            PG8_WAIT_L(8); PG8_BAR; PG8_WAIT_L(0); PG8_MMA(0, 0, At, B0); PG8_BAR; PG8_SCHED;
            PG8_LDB(B1, 1, 1); PG8_STAGE(PG8_SB(1, 0), b3, voffB);
            PG8_BAR; PG8_WAIT_L(0); PG8_MMA(0, 1, At, B1); PG8_BAR;
            PG8_LDA(At, 1, 1); PG8_STAGE(PG8_SA(1, 0), a3, voffA);
            PG8_BAR; PG8_WAIT_L(0); PG8_MMA(1, 0, At, B0); PG8_BAR; PG8_SCHED;
            PG8_STAGE(PG8_SB(1, 1), b3 + hstep, voffB);
            PG8_WAIT_V(6); PG8_BAR; PG8_MMA(1, 1, At, B1); PG8_BAR;
        }
        PG8_STAMP();
        if constexpr (!Epi::AFTER_DRAIN) { E(acc, cur, wr, wc, fr, fq); S.done(cur); }
        PG8_STAMP();
        if (!has_next) break;
#pragma unroll
        for (int a = 0; a < 2; ++a)
#pragma unroll
            for (int b = 0; b < 2; ++b)
#pragma unroll
                for (int m = 0; m < 4; ++m)
#pragma unroll
                    for (int n = 0; n < 2; ++n) acc[a][b][m][n] = (f32x4){0.f, 0.f, 0.f, 0.f};
        cur = nxt; cA = nA; cB = nB; ++ui;
    }
    PG8_WAIT_V(0);
    if (wr == 0) PG8_BAR;
    PG8_BAR;
    if constexpr (Epi::AFTER_DRAIN) { E.fused(acc, cur, wr, wc, fr, fq, lds, wid, lane); S.done(cur); }
    PG8_STAMP();
    if (STAMP && wid == 0) { stamps[lane] = lane < nts ? (((unsigned long long)(unsigned)ts_hi << 32) | (unsigned)ts_lo) : 0ull;
        if (lane == 62) stamps[62] = rt_entry; if (lane == 63) stamps[63] = (unsigned long long)wall_clock64(); }
#undef PG8_STAMP
#undef PG8_SA
#undef PG8_SB
#undef PG8_STAGE
#undef PG8_LDA
#undef PG8_LDB
#undef PG8_MMA
#undef PG8_WAIT_V
#undef PG8_WAIT_L
#undef PG8_BAR
#undef PG8_SCHED
}
}
using namespace pg8;
namespace cg = cooperative_groups;
typedef float f32x16 __attribute__((ext_vector_type(16)));
typedef unsigned u32x2 __attribute__((ext_vector_type(2)));
#define LAS __attribute__((address_space(3)))
#define DI __device__ __forceinline__

constexpr int T = 49152, TP = 16384, RWC = 1856;
constexpr size_t MiB = (size_t)1 << 20;
constexpr size_t O_W1T = 0, O_W2T = 8 * MiB, O_WPGT = 16 * MiB, O_WPLET = 18 * MiB, O_GUPT = 18 * MiB + 512 * 1024, O_WUPF = O_GUPT + 128 * 1024,
    O_WUPB = O_WUPF + 64 * 1024, O_AUPT = O_WUPB + 64 * 1024, O_RSTD1 = 19 * MiB, O_BONUS = 19 * MiB + 256 * 1024, O_SSQ2 = 21 * MiB, O_SSQ3 = 24 * MiB,
    O_CTR = 27 * MiB, O_BAR = 27 * MiB + 4096, O_CARU = 28 * MiB, O_CARP = 30 * MiB, O_XB = 32 * MiB, O_ZRW = 128 * MiB, O_YA = 302 * MiB, O_YF = 350 * MiB, O_YBK = 398 * MiB, O_YB = 446 * MiB, O_G = 128 * MiB,
    O_MG = 350 * MiB, O_HID = 128 * MiB, O_G7 = 128 * MiB, O_PB = 224 * MiB, O_WINT = 496 * MiB, O_WGT = 503 * MiB, O_WAT = 507 * MiB, O_WBT = 508 * MiB,
    O_WOT = 509 * MiB, WS_NEED = 512 * MiB;
constexpr int LDS_BYTES = 3 * 11520 * 4 + 128;

DI float bflo(unsigned u) { return __uint_as_float(u << 16); }
DI float bfhi(unsigned u) { return __uint_as_float(u & 0xffff0000u); }
DI float sigm(float x) { return __builtin_amdgcn_rcpf(1.0f + __expf(-x)); }
DI u32x4 pack8(const float* f) { u32x4 w; w.x = cvt_pk_bf16(f[0], f[1]); w.y = cvt_pk_bf16(f[2], f[3]); w.z = cvt_pk_bf16(f[4], f[5]); w.w = cvt_pk_bf16(f[6], f[7]); return w; }
DI u32x4 pack8v(f32x4 a, f32x4 b) { u32x4 w; w.x = cvt_pk_bf16(a[0], a[1]); w.y = cvt_pk_bf16(a[2], a[3]); w.z = cvt_pk_bf16(b[0], b[1]); w.w = cvt_pk_bf16(b[2], b[3]); return w; }
DI u32x2 pack4v(f32x4 a) { u32x2 w; w.x = cvt_pk_bf16(a[0], a[1]); w.y = cvt_pk_bf16(a[2], a[3]); return w; }
DI void unpack8(u32x4 w, f32x4& a, f32x4& b) { a = (f32x4){bflo(w.x), bfhi(w.x), bflo(w.y), bfhi(w.y)}; b = (f32x4){bflo(w.z), bfhi(w.z), bflo(w.w), bfhi(w.w)}; }
DI f32x4 unpack4(u32x2 w) { return (f32x4){bflo(w.x), bfhi(w.x), bflo(w.y), bfhi(w.y)}; }
DI float dpp_xor1(float x) { return __int_as_float(__builtin_amdgcn_mov_dpp(__float_as_int(x), 0xB1, 0xF, 0xF, true)); }
DI float dpp_xor2(float x) { return __int_as_float(__builtin_amdgcn_mov_dpp(__float_as_int(x), 0x4E, 0xF, 0xF, true)); }
DI void wave_lds_fence() { asm volatile("s_waitcnt lgkmcnt(0)" ::: "memory"); __builtin_amdgcn_wave_barrier(); }
#define MFMA32(a, b, c) __builtin_amdgcn_mfma_f32_32x32x16_bf16((a), (b), (c), 0, 0, 0)
#define MFMA16(a, b, c) __builtin_amdgcn_mfma_f32_16x16x32_bf16((a), (b), (c), 0, 0, 0)


#define XB_TMO      128
#define XB_XCNT(j)  (256  + 64 * (j))
#define XB_XSUB(j)  (1280 + 64 * (j))
#define XB_XGEN(j)  (2304 + 64 * (j))
#define XB_TOP      3328
#define XB_TOPGEN   3392
#define XCD_BAR_WORDS 3456
#define XB_SPIN_CAP (1u << 20)
DI unsigned xb_ld(unsigned* p)              { return __hip_atomic_load(p, __ATOMIC_RELAXED, __HIP_MEMORY_SCOPE_AGENT); }
DI unsigned xb_add(unsigned* p, unsigned v) { return __hip_atomic_fetch_add(p, v, __ATOMIC_RELAXED, __HIP_MEMORY_SCOPE_AGENT); }
DI unsigned xb_xcc_id() { return (unsigned)__builtin_amdgcn_s_getreg((3 << 11) | 20) & 0xFu; }
#define XB_SPIN(cond, bar) do { unsigned _sp = 0; while (cond) { __builtin_amdgcn_s_sleep(1); \
    if ((++_sp & 255u) == 0u) { if (xb_ld(&(bar)[XB_TMO])) break; if (_sp > XB_SPIN_CAP) { atomicAdd(&(bar)[XB_TMO], 1u); break; } } } } while (0)
struct XcdBarrier { unsigned* bar; unsigned x; volatile LAS unsigned* st; };
DI void xcd_barrier_complete(unsigned* bar, unsigned x, unsigned& nloc, unsigned& nx) {
    const unsigned G = gridDim.x;
    unsigned sum, cnt, mine, sp = 0u;
    for (;;) {
        sum = 0u; cnt = 0u; mine = 0u;
#pragma unroll
        for (unsigned j = 0; j < 16; ++j) { const unsigned c = xb_ld(&bar[XB_XCNT(j)]); sum += c; cnt += (c > 0u) ? 1u : 0u; mine = (j == x) ? c : mine; }
        if (sum == G) break;
        __builtin_amdgcn_s_sleep(1);
        if ((++sp & 255u) == 0u) { if (xb_ld(&bar[XB_TMO])) break; if (sp > XB_SPIN_CAP) { atomicAdd(&bar[XB_TMO], 1u); break; } }
    }
    nloc = mine > 0u ? mine : 1u; nx = cnt > 0u ? cnt : 1u;
}
DI void xcd_barrier(const XcdBarrier& b, const bool leader) {
    asm volatile("s_waitcnt vmcnt(0)" ::: "memory");
    __syncthreads();
    if (leader) {
        unsigned* bar = b.bar;
        __builtin_amdgcn_s_waitcnt(0);
        unsigned nloc = b.st[0], nx = b.st[1];
        if (nloc == 0u) { xcd_barrier_complete(bar, b.x, nloc, nx); b.st[0] = nloc; b.st[1] = nx; }
        const unsigned old = xb_add(&bar[XB_XSUB(b.x)], 1u);
        const unsigned gen = old / nloc;
        if (old + 1u == (gen + 1u) * nloc) {
            __builtin_amdgcn_fence(__ATOMIC_RELEASE, "agent");
            asm volatile("s_waitcnt vmcnt(0)" ::: "memory");
            const unsigned og = xb_add(&bar[XB_TOP], 1u);
            const unsigned tg = og / nx;
            if (og + 1u == (tg + 1u) * nx) xb_add(&bar[XB_TOPGEN], 1u);
            else XB_SPIN(xb_ld(&bar[XB_TOPGEN]) == tg, bar);
            __builtin_amdgcn_fence(__ATOMIC_ACQUIRE, "agent");
            xb_add(&bar[XB_XGEN(b.x)], 1u);
            asm volatile("s_waitcnt vmcnt(0)" ::: "memory");
        } else {
            XB_SPIN(xb_ld(&bar[XB_XGEN(b.x)]) == gen, bar);
            __builtin_amdgcn_fence(__ATOMIC_ACQUIRE, "agent");
            asm volatile("s_waitcnt vmcnt(0)" ::: "memory");
        }
    }
    __syncthreads();
}
DI void conv8(const bf16_t* z, size_t rowoff, bool hp, bool hn, const float* cw, int col, float* out) {
    const u32x4 zz = (u32x4){0u, 0u, 0u, 0u};
    const u32x4 a = hp ? *(const u32x4*)(z + rowoff - RWC) : zz;
    const u32x4 b = *(const u32x4*)(z + rowoff);
    const u32x4 c = hn ? *(const u32x4*)(z + rowoff + RWC) : zz;
    const f32x4 w0a = *(const f32x4*)(cw + col), w0b = *(const f32x4*)(cw + col + 4);
    const f32x4 w1a = *(const f32x4*)(cw + RWC + col), w1b = *(const f32x4*)(cw + RWC + col + 4);
    const f32x4 w2a = *(const f32x4*)(cw + 2 * RWC + col), w2b = *(const f32x4*)(cw + 2 * RWC + col + 4);
    f32x4 a0, a1, b0, b1, c0, c1; unpack8(a, a0, a1); unpack8(b, b0, b1); unpack8(c, c0, c1);
    const f32x4 o0 = a0 * w0a + b0 * w1a + c0 * w2a, o1 = a1 * w0b + b1 * w1b + c1 * w2b;
#pragma unroll
    for (int j = 0; j < 4; ++j) { out[j] = o0[j]; out[4 + j] = o1[j]; }
}
DI f32x4 conv4(const bf16_t* z, size_t rowoff, bool hp, bool hn, const float* cw, int col) {
    const u32x2 zz = (u32x2){0u, 0u};
    const u32x2 a = hp ? *(const u32x2*)(z + rowoff - RWC) : zz;
    const u32x2 b = *(const u32x2*)(z + rowoff);
    const u32x2 c = hn ? *(const u32x2*)(z + rowoff + RWC) : zz;
    return unpack4(a) * *(const f32x4*)(cw + col) + unpack4(b) * *(const f32x4*)(cw + RWC + col) + unpack4(c) * *(const f32x4*)(cw + 2 * RWC + col);
}

struct EpiG1 {
    static constexpr bool PERM = true, AFTER_DRAIN = false;
    bf16_t *q, *k, *vT, *zrw; const float *rstd, *qg, *kg;
    __device__ __forceinline__ void operator()(const f32x4 (&acc)[2][2][4][2], const Unit& u, int wr, int wc, int fr, int fq) const {
        const int row0 = u.pm * BM + wr * 64 + fr;
        float rsv[2][4];
#pragma unroll
        for (int ai = 0; ai < 2; ++ai)
#pragma unroll
            for (int m = 0; m < 4; ++m) rsv[ai][m] = rstd[row0 + ai * HALF + m * 16];
        if (u.pn < 6) {
            const int kind = u.pn >> 1, head = 4 * (u.pn & 1) + wc;
            if (kind < 2) {
                bf16_t* dst = kind ? k : q; const float* gn = kind ? kg : qg;
                f32x4 g0[2][2];
#pragma unroll
                for (int bj = 0; bj < 2; ++bj)
#pragma unroll
                    for (int n = 0; n < 2; ++n) g0[bj][n] = *(const f32x4*)(gn + 32 * bj + 8 * fq + 4 * n);
#pragma unroll
                for (int ai = 0; ai < 2; ++ai)
#pragma unroll
                    for (int m = 0; m < 4; ++m) {
                        const int row = row0 + ai * HALF + m * 16; const float rs = rsv[ai][m];
                        f32x4 v[2][2]; float ss = 0.f;
#pragma unroll
                        for (int bj = 0; bj < 2; ++bj)
#pragma unroll
                            for (int n = 0; n < 2; ++n) { v[bj][n] = acc[ai][bj][m][n] * rs; const f32x4 s = v[bj][n] * v[bj][n]; ss += (s[0] + s[1]) + (s[2] + s[3]); }
                        ss += __shfl_xor(ss, 16); ss += __shfl_xor(ss, 32);
                        const float sc = rsqrtf(ss * (1.0f / 64.0f) + 1e-6f);
#pragma unroll
                        for (int bj = 0; bj < 2; ++bj)
                            *(u32x4*)(dst + (size_t)row * 512 + head * 64 + 32 * bj + 8 * fq) = pack8v(v[bj][0] * sc * g0[bj][0], v[bj][1] * sc * g0[bj][1]);
                    }
            } else {
#pragma unroll
                for (int ai = 0; ai < 2; ++ai)
#pragma unroll
                    for (int m = 0; m < 4; ++m) {
                        const int row = row0 + ai * HALF + m * 16; const float rs = rsv[ai][m];
#pragma unroll
                        for (int bj = 0; bj < 2; ++bj)
#pragma unroll
                            for (int n = 0; n < 2; ++n) {
                                const f32x4 v = acc[ai][bj][m][n] * rs; const unsigned p0 = cvt_pk_bf16(v[0], v[1]), p1 = cvt_pk_bf16(v[2], v[3]);
                                bf16_t* d = vT + (size_t)(head * 64 + 32 * bj + 8 * fq + 4 * n) * T + row;
                                d[0] = (bf16_t)(p0 & 0xffffu); d[T] = (bf16_t)(p0 >> 16); d[2 * (size_t)T] = (bf16_t)(p1 & 0xffffu); d[3 * (size_t)T] = (bf16_t)(p1 >> 16);
                            }
                    }
            }
        } else {
            const int col0 = (u.pn - 6) * BM + wc * 32 + 8 * fq;
#pragma unroll
            for (int ai = 0; ai < 2; ++ai)
#pragma unroll
                for (int m = 0; m < 4; ++m) {
                    const int row = row0 + ai * HALF + m * 16; const float rs = rsv[ai][m];
#pragma unroll
                    for (int bj = 0; bj < 2; ++bj) { const int col = col0 + bj * HALF;
                        if (col < RWC) *(u32x4*)(zrw + (size_t)row * RWC + col) = pack8v(acc[ai][bj][m][0] * rs, acc[ai][bj][m][1] * rs); }
                }
        }
    }
};
template <int MODE> struct EpiB {
    static constexpr bool PERM = true, AFTER_DRAIN = false;
    bf16_t* O; int ld; const float* rs; const bf16_t* G; int ldg;
    __device__ __forceinline__ void operator()(const f32x4 (&acc)[2][2][4][2], const Unit& u, int wr, int wc, int fr, int fq) const {
        const int row0 = u.pm * BM + wr * 64 + fr, col0 = u.pn * BM + wc * 32 + 8 * fq;
        float rr[2][4];
#pragma unroll
        for (int ai = 0; ai < 2; ++ai)
#pragma unroll
            for (int m = 0; m < 4; ++m) {
                const int row = row0 + ai * HALF + m * 16; rr[ai][m] = 1.f;
                if (MODE == 0) rr[ai][m] = rs[row];
                if (MODE == 3) { const f32x4* p = (const f32x4*)(rs + (size_t)row * 16); const f32x4 s = (p[0] + p[1]) + (p[2] + p[3]); rr[ai][m] = rsqrtf(((s[0] + s[1]) + (s[2] + s[3])) * (1.0f / 1024.0f) + 1e-6f); }
            }
#pragma unroll
        for (int ai = 0; ai < 2; ++ai)
#pragma unroll
            for (int mh = 0; mh < 2; ++mh) {
                u32x4 gq[2][2], oq[2][2];
                if (MODE == 1 || MODE == 2) {
#pragma unroll
                    for (int mm = 0; mm < 2; ++mm)
#pragma unroll
                        for (int bj = 0; bj < 2; ++bj) { const int row = row0 + ai * HALF + (2 * mh + mm) * 16;
                            gq[mm][bj] = *(const u32x4*)(G + (size_t)row * ldg + col0 + bj * HALF);
                            if (MODE == 2) oq[mm][bj] = *(const u32x4*)(O + (size_t)row * ld + col0 + bj * HALF); }
                }
#pragma unroll
                for (int mm = 0; mm < 2; ++mm)
#pragma unroll
                    for (int bj = 0; bj < 2; ++bj) {
                        const int m = 2 * mh + mm, row = row0 + ai * HALF + m * 16; const float r = rr[ai][m];
                        const size_t off = (size_t)row * ld + col0 + bj * HALF;
                        f32x4 v0 = acc[ai][bj][m][0], v1 = acc[ai][bj][m][1];
                        if (MODE == 0) {
#pragma unroll
                            for (int j = 0; j < 4; ++j) { v0[j] = sigm(v0[j] * r); v1[j] = sigm(v1[j] * r); } }
                        if (MODE == 1 || MODE == 2) { f32x4 g0, g1; unpack8(gq[mm][bj], g0, g1); v0 *= g0; v1 *= g1; }
                        if (MODE == 2) { f32x4 m0, m1; unpack8(oq[mm][bj], m0, m1); v0 += m0; v1 += m1; }
                        if (MODE == 3) {
#pragma unroll
                            for (int j = 0; j < 4; ++j) { const float a_ = fmaxf(v0[j] * r, 0.f), b_ = fmaxf(v1[j] * r, 0.f); v0[j] = a_ * a_; v1[j] = b_ * b_; } }
                        *(u32x4*)(O + off) = pack8v(v0, v1);
                    }
            }
    }
};
template <int MODE> struct EpiF {
    static constexpr bool PERM = false, AFTER_DRAIN = false;
    const float* resP; const float* resS; float* out; bf16_t* hb; float* ssq; const float* ssin; const bf16_t* r16;
    __device__ __forceinline__ void operator()(const f32x4 (&acc)[2][2][4][2], const Unit& u, int wr, int wc, int fr, int fq) const {
        const int row0 = u.pm * BM + wr * 64 + fr, col0 = u.pn * BM + wc * 32 + 4 * fq;
        float rr[2][4];
#pragma unroll
        for (int ai = 0; ai < 2; ++ai)
#pragma unroll
            for (int m = 0; m < 4; ++m) { rr[ai][m] = 1.f;
                if (MODE == 1) { const int row = row0 + ai * HALF + m * 16; const f32x4* p = (const f32x4*)(ssin + (size_t)row * 16); const f32x4 s = (p[0] + p[1]) + (p[2] + p[3]); rr[ai][m] = rsqrtf(((s[0] + s[1]) + (s[2] + s[3])) * (1.0f / 1024.0f) + 1e-6f); } }
#pragma unroll
        for (int ai = 0; ai < 2; ++ai)
#pragma unroll
            for (int mh = 0; mh < 2; ++mh) {
                u32x2 hq[2][2][2]; f32x4 oq[2][2][2];
                if (MODE == 0 || MODE == 2) {
#pragma unroll
                    for (int mm = 0; mm < 2; ++mm)
#pragma unroll
                        for (int bj = 0; bj < 2; ++bj)
#pragma unroll
                            for (int n = 0; n < 2; ++n) { const size_t off = (size_t)(row0 + ai * HALF + (2 * mh + mm) * 16) * 1024 + col0 + bj * HALF + n * 16;
                                hq[mm][bj][n] = *(const u32x2*)(hb + off); if (MODE == 2) oq[mm][bj][n] = *(const f32x4*)(out + off); }
                }
#pragma unroll
                for (int mm = 0; mm < 2; ++mm) {
                    const int m = 2 * mh + mm, row = row0 + ai * HALF + m * 16; const float r = rr[ai][m]; float ssl = 0.f;
#pragma unroll
                    for (int bj = 0; bj < 2; ++bj)
#pragma unroll
                        for (int n = 0; n < 2; ++n) {
                            const int col = col0 + bj * HALF + n * 16; const size_t off = (size_t)row * 1024 + col;
                            f32x4 v = acc[ai][bj][m][n];
                            if (MODE == 0) { v += unpack4(hq[mm][bj][n]); if (out) *(f32x4*)(out + off) = v;
                                *(u32x2*)(hb + off) = pack4v(v); const f32x4 s = v * v; ssl += (s[0] + s[1]) + (s[2] + s[3]); }
                            if (MODE == 1) {
#pragma unroll
                                for (int j = 0; j < 4; ++j) v[j] = sigm(v[j] * r);
                                *(u32x2*)(hb + off) = pack4v(v); }
                            if (MODE == 2) { const f32x4 g = unpack4(hq[mm][bj][n]); *(f32x4*)(out + off) = oq[mm][bj][n] + g * v; }
                        }
                    if (MODE == 0) { ssl += __shfl_xor(ssl, 16); ssl += __shfl_xor(ssl, 32); if (fq == 0) ssq[(size_t)row * 16 + u.pn * 4 + wc] = ssl; }
                }
            }
    }
};
DI void p0_tile_load(const float* W, int ldw, const float* gs, int mode, int col0, int tk, int tn, int tid, f32x4 (&v)[2]) {
#pragma unroll
    for (int i = 0; i < 2; ++i) {
        const int kk = (tid >> 4) + 32 * i, n = tn * 64 + (tid & 15) * 4; int col = col0 + n;
        if (mode == 1) { if (n < 1536) { const int pn = n >> 8, j = n & 255; col = 256 * pn + 64 * ((j >> 5) & 3) + 32 * (j >> 7) + (j & 31); } else if (n >= 3392) col = -1; }
        v[i] = (f32x4){0.f, 0.f, 0.f, 0.f};
        if (col >= 0) v[i] = *(const f32x4*)(W + (size_t)(tk * 64 + kk) * ldw + col);
        if (gs) v[i] *= gs[tk * 64 + kk];
    }
}
DI void p0_transpose(LAS float* tl, const float* W, int ldw, int K, int Nrows, bf16_t* dst, const float* gs, int mode, int col0, int G, int b, int tid) {
    const int ntk = K / 64, ntn = Nrows / 64, nt = ntk * ntn;
    f32x4 v[2], vn[2];
    if (b < nt) p0_tile_load(W, ldw, gs, mode, col0, b % ntk, b / ntk, tid, v);
    for (int tile = b; tile < nt; tile += G) {
        const int tk = tile % ntk, tn = tile / ntk;
#pragma unroll
        for (int i = 0; i < 2; ++i) { const int kk = (tid >> 4) + 32 * i;
#pragma unroll
            for (int j = 0; j < 4; ++j) tl[kk * 65 + (tid & 15) * 4 + j] = v[i][j]; }
        const int nx = tile + G;
        if (nx < nt) p0_tile_load(W, ldw, gs, mode, col0, nx % ntk, nx / ntk, tid, vn);
        __syncthreads();
        { const int n = tid >> 3, k8 = (tid & 7) * 8; float f[8];
#pragma unroll
          for (int j = 0; j < 8; ++j) f[j] = tl[(k8 + j) * 65 + n];
          *(u32x4*)(dst + (size_t)(tn * 64 + n) * K + tk * 64 + k8) = pack8(f); }
        __syncthreads();
        v[0] = vn[0]; v[1] = vn[1];
    }
}

DI void na_item(int item, const bf16_t* q, const bf16_t* k, const bf16_t* vT, const float* relb, bf16_t* ya, int lane) {
    asm volatile("" : "+v"(lane));
    const int cb = item & 3, h = (item >> 2) & 7, pr = item >> 5;
    const int rows = pr < 256 ? 128 : 32;
    const int r = pr < 256 ? (pr & 127) : ((pr - 256) & 31);
    const int rs0 = min(max(r - 4, 0), rows - 8);
    const int prbase = pr - r + rs0;
    const int blk = min(max(cb * 16 - 8, 0), 32);
    const int l16 = lane & 15, g = lane >> 4;
    const bf16_t* qp = q + (size_t)(pr * 64 + cb * 16 + l16) * 512 + h * 64 + 8 * g;
    const bf16x8 qf0 = *(const bf16x8*)qp, qf1 = *(const bf16x8*)(qp + 32);
    f32x4 sc[8][2];
#pragma unroll
    for (int s = 0; s < 8; ++s)
#pragma unroll
        for (int u = 0; u < 2; ++u) {
            const int tok = (prbase + s) * 64 + blk + 8 * (l16 >> 2) + 4 * u + (l16 & 3);
            const bf16_t* kp = k + (size_t)tok * 512 + h * 64 + 8 * g;
            const bf16x8 kf0 = *(const bf16x8*)kp, kf1 = *(const bf16x8*)(kp + 32);
            f32x4 a = (f32x4){0.f, 0.f, 0.f, 0.f};
            a = MFMA16(kf0, qf0, a); a = MFMA16(kf1, qf1, a);
            sc[s][u] = a;
            if (u == 1 && (s & 1)) asm volatile("" ::: "memory");
        }
    const int qc = cb * 16 + l16, cs = min(max(qc - 8, 0), 48);
    const float* rb = relb + h * 465;
    float mx = -3.0e38f;
#pragma unroll
    for (int s = 0; s < 8; ++s) {
        const int dr = rs0 + s - r + 7;
#pragma unroll
        for (int u = 0; u < 2; ++u)
#pragma unroll
            for (int j = 0; j < 4; ++j) {
                const int kc = blk + 8 * g + 4 * u + j; const bool valid = (kc >= cs) && (kc < cs + 16);
                const int dc = min(max(kc - qc + 15, 0), 30);
                float v = sc[s][u][j] * 0.125f + rb[dr * 31 + dc];
                v = valid ? v : -1.0e30f; sc[s][u][j] = v; mx = fmaxf(mx, v);
            }
    }
    mx = fmaxf(mx, __shfl_xor(mx, 16)); mx = fmaxf(mx, __shfl_xor(mx, 32));
    float sum = 0.f;
#pragma unroll
    for (int s = 0; s < 8; ++s)
#pragma unroll
        for (int u = 0; u < 2; ++u)
#pragma unroll
            for (int j = 0; j < 4; ++j) { const float p = __expf(sc[s][u][j] - mx); sc[s][u][j] = p; sum += p; }
    sum += __shfl_xor(sum, 16); sum += __shfl_xor(sum, 32);
    const float inv = 1.0f / sum;
    f32x4 o[4];
#pragma unroll
    for (int dt = 0; dt < 4; ++dt) o[dt] = (f32x4){0.f, 0.f, 0.f, 0.f};
#pragma unroll
    for (int s = 0; s < 8; ++s) {
        const u32x4 pw = pack8v(sc[s][0] * inv, sc[s][1] * inv); const bf16x8 pa = __builtin_bit_cast(bf16x8, pw);
#pragma unroll
        for (int dt = 0; dt < 4; ++dt) {
            const bf16x8 vf = *(const bf16x8*)(vT + (size_t)(h * 64 + 16 * dt + l16) * T + (prbase + s) * 64 + blk + 8 * g);
            o[dt] = MFMA16(pa, vf, o[dt]);
        }
        if (s & 1) asm volatile("" ::: "memory");
    }
#pragma unroll
    for (int dt = 0; dt < 4; ++dt)
#pragma unroll
        for (int j = 0; j < 4; ++j) {
            const unsigned p = cvt_pk_bf16(o[dt][j], 0.f);
            ya[(size_t)(pr * 64 + cb * 16 + 4 * g + j) * 512 + h * 64 + 16 * dt + l16] = (bf16_t)(p & 0xffffu);
        }
}

struct ScanArgs { const bf16_t* zrw; const float* convw; const bf16_t *wupTf, *wupTb, *aupT; const float *w0f, *w0b, *a0, *k_k, *k_a, *r_k; float* bonus; bf16_t *yf, *ybk; };
struct ScanJob { int tok0, Ls, seg0, nst, h, dir, init, store_y; float* carry; };
DI float red8(float x) {
    x += dpp_xor1(x); x += dpp_xor2(x);
    x += __int_as_float(__builtin_amdgcn_mov_dpp(__float_as_int(x), 0x141, 0xF, 0xF, true));
    return x;
}
DI void red8x4(float& a, float& b, float& c, float& d) {
    asm volatile("s_nop 1\n\t"
                 "v_add_f32_dpp %0, %0, %0 quad_perm:[1,0,3,2] row_mask:0xf bank_mask:0xf bound_ctrl:1\n\t"
                 "v_add_f32_dpp %1, %1, %1 quad_perm:[1,0,3,2] row_mask:0xf bank_mask:0xf bound_ctrl:1\n\t"
                 "v_add_f32_dpp %2, %2, %2 quad_perm:[1,0,3,2] row_mask:0xf bank_mask:0xf bound_ctrl:1\n\t"
                 "v_add_f32_dpp %3, %3, %3 quad_perm:[1,0,3,2] row_mask:0xf bank_mask:0xf bound_ctrl:1\n\t"
                 "v_add_f32_dpp %0, %0, %0 quad_perm:[2,3,0,1] row_mask:0xf bank_mask:0xf bound_ctrl:1\n\t"
                 "v_add_f32_dpp %1, %1, %1 quad_perm:[2,3,0,1] row_mask:0xf bank_mask:0xf bound_ctrl:1\n\t"
                 "v_add_f32_dpp %2, %2, %2 quad_perm:[2,3,0,1] row_mask:0xf bank_mask:0xf bound_ctrl:1\n\t"
                 "v_add_f32_dpp %3, %3, %3 quad_perm:[2,3,0,1] row_mask:0xf bank_mask:0xf bound_ctrl:1\n\t"
                 "v_add_f32_dpp %0, %0, %0 row_half_mirror row_mask:0xf bank_mask:0xf bound_ctrl:1\n\t"
                 "v_add_f32_dpp %1, %1, %1 row_half_mirror row_mask:0xf bank_mask:0xf bound_ctrl:1\n\t"
                 "v_add_f32_dpp %2, %2, %2 row_half_mirror row_mask:0xf bank_mask:0xf bound_ctrl:1\n\t"
                 "v_add_f32_dpp %3, %3, %3 row_half_mirror row_mask:0xf bank_mask:0xf bound_ctrl:1"
                 : "+v"(a), "+v"(b), "+v"(c), "+v"(d));
}
DI void team_bar(LAS unsigned* bar, unsigned& k, int lane) {
    asm volatile("s_waitcnt lgkmcnt(0)" ::: "memory");
    k += 2u;
    if (lane == 0) __hip_atomic_fetch_add(bar, 1u, __ATOMIC_RELAXED, __HIP_MEMORY_SCOPE_WORKGROUP);
    while (__hip_atomic_load(bar, __ATOMIC_RELAXED, __HIP_MEMORY_SCOPE_WORKGROUP) < k) __builtin_amdgcn_s_sleep(1);
    asm volatile("s_waitcnt lgkmcnt(0)" ::: "memory");
}
DI void conv8R(const LAS float* raw, int rr, int pc, bool hp, bool hn, const LAS float* cw, float* out) {
    const u32x4 zz = (u32x4){0u, 0u, 0u, 0u};
    u32x4 a = *(const LAS u32x4*)(raw + (rr * 40 + pc) * 4); const u32x4 b = *(const LAS u32x4*)(raw + ((rr + 1) * 40 + pc) * 4); u32x4 c = *(const LAS u32x4*)(raw + ((rr + 2) * 40 + pc) * 4);
    a = hp ? a : zz; c = hn ? c : zz;
    const f32x4 w0a = *(const LAS f32x4*)(cw), w0b = *(const LAS f32x4*)(cw + 4), w1a = *(const LAS f32x4*)(cw + 64), w1b = *(const LAS f32x4*)(cw + 68), w2a = *(const LAS f32x4*)(cw + 128), w2b = *(const LAS f32x4*)(cw + 132);
    f32x4 a0, a1, b0, b1, c0, c1; unpack8(a, a0, a1); unpack8(b, b0, b1); unpack8(c, c0, c1);
    const f32x4 o0 = a0 * w0a + b0 * w1a + c0 * w2a, o1 = a1 * w0b + b1 * w1b + c1 * w2b;
#pragma unroll
    for (int j = 0; j < 4; ++j) { out[j] = o0[j]; out[4 + j] = o1[j]; }
}
DI void scan_team(const ScanJob J, const int mem, LAS float* L, LAS float* RAW, LAS float* TB, LAS unsigned* bar, unsigned& bk, f32x4 (&SI)[4][2], const ScanArgs& A, int lane) {
    const int tok0 = J.tok0, Ls = J.Ls, h = J.h, dir = J.dir; const bool pmode = (J.init == 1);
    LAS float *LW = L, *LKK = L + 1024, *LB = L + 2048, *LKT = L + 3072, *LR = L + 4096, *LV = L + 5120;
    LAS float* YB = L + 9216;
    const bf16_t* wupT = dir ? A.wupTb : A.wupTf; const float* w0 = dir ? A.w0b : A.w0f; bf16_t* yout = dir ? A.ybk : A.yf;
    const int dwcol = 1536 + 64 * dir;
#pragma unroll
    for (int tap = 0; tap < 3; ++tap) {
#pragma unroll
        for (int vec = 0; vec < 3; ++vec) TB[(vec * 3 + tap) * 64 + lane] = A.convw[tap * RWC + vec * 512 + h * 64 + lane];
        TB[576 + tap * 64 + lane] = A.convw[tap * RWC + dwcol + lane];
        TB[576 + 192 + tap * 64 + lane] = A.convw[tap * RWC + 1664 + lane];
    }
    TB[960 + lane] = A.k_k[h * 64 + lane]; TB[1024 + lane] = A.k_a[h * 64 + lane]; TB[1088 + lane] = A.r_k[h * 64 + lane];
    TB[1152 + lane] = w0[h * 64 + lane]; TB[1216 + lane] = A.a0[h * 64 + lane];
    f32x2 S[4][4];
#pragma unroll
    for (int r = 0; r < 4; ++r)
#pragma unroll
        for (int j = 0; j < 2; ++j) { f32x4 z = SI[r][j];
            if (J.init != 2) {
#pragma unroll
                for (int e = 0; e < 4; ++e) z[e] = (pmode && (32 * mem + 4 * (lane >> 3) + r == 8 * (lane & 7) + 4 * j + e)) ? 1.f : 0.f; }
            S[r][2 * j] = (f32x2){z[0], z[1]}; S[r][2 * j + 1] = (f32x2){z[2], z[3]}; }
    int prow[6], pcol[6];
#pragma unroll
    for (int i = 0; i < 6; ++i) { const int p = (mem * 6 + i) * 64 + lane, row = p / 40, rem = p - row * 40, g = rem >> 3, ch = rem & 7;
        prow[i] = row > 17 ? 17 : row; pcol[i] = (g == 0 ? h * 64 : g == 1 ? 512 + h * 64 : g == 2 ? 1024 + h * 64 : g == 3 ? dwcol : 1664) + 8 * ch; }
#define SC_DMA(T0) do { _Pragma("unroll") for (int i = 0; i < 6; ++i) { int tr_ = (T0) - 1 + prow[i]; tr_ = tr_ < tok0 ? tok0 : (tr_ > tok0 + Ls - 1 ? tok0 + Ls - 1 : tr_); \
            __builtin_amdgcn_global_load_lds((const unsigned*)(A.zrw + (size_t)tr_ * RWC + pcol[i]), (LAS unsigned*)(RAW + (mem * 6 + i) * 256), 16, 0, 0); } } while (0)
    bf16x8 AF[2][4];
    { const bf16_t* wt0 = mem ? A.aupT : wupT;
#pragma unroll
      for (int ks = 0; ks < 2; ++ks)
#pragma unroll
          for (int mt = 0; mt < 4; ++mt) AF[ks][mt] = *(const bf16x8*)(wt0 + (size_t)(h * 64 + 16 * mt + (lane & 15)) * 64 + 32 * ks + 8 * (lane >> 4)); }
    const int nch = J.nst / 16;
    SC_DMA(J.seg0 + (dir ? nch - 1 : 0) * 16);
    asm volatile("s_waitcnt vmcnt(0)" ::: "memory");
    team_bar(bar, bk, lane);
    for (int ci = 0; ci < nch; ++ci) {
        const int c = dir ? nch - 1 - ci : ci; const int t0 = J.seg0 + c * 16;
        int ln = lane; asm volatile("" : "+v"(ln));
        {
            const int tk = ln & 15, hq = ln >> 4; const int t = t0 + tk; const int pos = t - tok0; const bool hp = pos > 0, hn = pos < Ls - 1;
            f32x4 acc[4];
#pragma unroll
            for (int mt = 0; mt < 4; ++mt) acc[mt] = (f32x4){0.f, 0.f, 0.f, 0.f};
#pragma unroll
            for (int ks = 0; ks < 2; ++ks) {
                const int kq = 32 * ks + 8 * hq; float x[8];
                conv8R(RAW, tk, (mem ? 32 : 24) + 4 * ks + hq, hp, hn, TB + 576 + mem * 192 + kq, x);
                if (mem == 0) {
#pragma unroll
                    for (int j = 0; j < 8; ++j) x[j] = 1.0f - 2.0f * __builtin_amdgcn_rcpf(__expf(2.0f * x[j]) + 1.0f); }
                const u32x4 pw = pack8(x); const bf16x8 bfrag = __builtin_bit_cast(bf16x8, pw);
#pragma unroll
                for (int mt = 0; mt < 4; ++mt) acc[mt] = MFMA16(AF[ks][mt], bfrag, acc[mt]);
            }
#pragma unroll
            for (int mt = 0; mt < 4; ++mt) {
                const int cc = 16 * mt + 4 * hq; const f32x4 bias = *(const LAS f32x4*)(TB + 1152 + mem * 64 + cc); f32x4 o;
#pragma unroll
                for (int j = 0; j < 4; ++j) { const float sg = sigm(bias[j] + acc[mt][j]); o[j] = mem ? sg : __expf(-0.606531f * sg); }
                *(LAS f32x4*)((mem ? LB : LW) + tk * 64 + cc) = o;
            }
        }
        team_bar(bar, bk, lane);
        {
            const int tk = 8 * mem + (ln >> 3), c0 = 8 * (ln & 7); const int t = t0 + tk; const int pos = t - tok0; const bool hp = pos > 0, hn = pos < Ls - 1;
            float rc[8], kc8[8], vc[8];
            if (J.store_y) conv8R(RAW, tk, (ln & 7), hp, hn, TB + c0, rc); else {
#pragma unroll
                for (int j = 0; j < 8; ++j) rc[j] = 0.f; }
            conv8R(RAW, tk, 8 + (ln & 7), hp, hn, TB + 192 + c0, kc8);
            if (!pmode) conv8R(RAW, tk, 16 + (ln & 7), hp, hn, TB + 384 + c0, vc); else {
#pragma unroll
                for (int j = 0; j < 8; ++j) vc[j] = 0.f; }
            const int o = tk * 64 + c0;
            const f32x4 a_lo = *(const LAS f32x4*)(LB + o), a_hi = *(const LAS f32x4*)(LB + o + 4);
            const f32x4 kk_lo = *(const LAS f32x4*)(TB + 960 + c0), kk_hi = *(const LAS f32x4*)(TB + 960 + c0 + 4);
            const f32x4 ka_lo = *(const LAS f32x4*)(TB + 1024 + c0), ka_hi = *(const LAS f32x4*)(TB + 1024 + c0 + 4);
            const f32x4 rk_lo = *(const LAS f32x4*)(TB + 1088 + c0), rk_hi = *(const LAS f32x4*)(TB + 1088 + c0 + 4);
            f32x4 kr[2], kt[2], av[2]; float n2 = 0.f, bon = 0.f;
#pragma unroll
            for (int j = 0; j < 8; ++j) {
                const float a = j < 4 ? a_lo[j & 3] : a_hi[j & 3], kkw = j < 4 ? kk_lo[j & 3] : kk_hi[j & 3], kaw = j < 4 ? ka_lo[j & 3] : ka_hi[j & 3], rkw = j < 4 ? rk_lo[j & 3] : rk_hi[j & 3];
                const float kraw = kc8[j] * kkw; n2 += kraw * kraw;
                const float ktv = kc8[j] * (1.0f + (a - 1.0f) * kaw); bon += rc[j] * ktv * rkw;
                kr[j >> 2][j & 3] = kraw; kt[j >> 2][j & 3] = ktv; av[j >> 2][j & 3] = a;
            }
            n2 = red8(n2); bon = red8(bon);
            const float inv = 1.0f / fmaxf(sqrtf(n2), 1e-12f);
            if (J.store_y) { *(LAS f32x4*)(LR + o) = (f32x4){rc[0], rc[1], rc[2], rc[3]}; *(LAS f32x4*)(LR + o + 4) = (f32x4){rc[4], rc[5], rc[6], rc[7]}; }
            if (pmode) {
#pragma unroll
                for (int j = 0; j < 8; ++j) vc[j] = 0.f; }
            *(LAS f32x4*)(LV + o) = (f32x4){vc[0], vc[1], vc[2], vc[3]}; *(LAS f32x4*)(LV + o + 4) = (f32x4){vc[4], vc[5], vc[6], vc[7]};
            *(LAS f32x4*)(LKT + o) = kt[0]; *(LAS f32x4*)(LKT + o + 4) = kt[1];
            const f32x4 k0 = kr[0] * inv, k1 = kr[1] * inv;
            *(LAS f32x4*)(LKK + o) = k0; *(LAS f32x4*)(LKK + o + 4) = k1;
            *(LAS f32x4*)(LB + o) = k0 * av[0]; *(LAS f32x4*)(LB + o + 4) = k1 * av[1];
            if (dir == 0 && (ln & 7) == 0 && J.store_y) A.bonus[(size_t)t * 8 + h] = bon;
        }
        team_bar(bar, bk, lane);
        if (ci + 1 < nch) { const int cn = dir ? nch - 2 - ci : ci + 1; SC_DMA(J.seg0 + cn * 16); }
        {
            const int kc = ln & 7, rg = ln >> 3;
#define SC_LOAD(C, ST) do { const int tt_ = dir ? 15 - (ST) : (ST); const int base_ = tt_ * 64 + 8 * kc; \
                C[0] = *(const LAS f32x4*)(LKK + base_); C[1] = *(const LAS f32x4*)(LKK + base_ + 4); C[2] = *(const LAS f32x4*)(LW + base_); C[3] = *(const LAS f32x4*)(LW + base_ + 4); \
                C[4] = *(const LAS f32x4*)(LB + base_); C[5] = *(const LAS f32x4*)(LB + base_ + 4); C[6] = *(const LAS f32x4*)(LKT + base_); C[7] = *(const LAS f32x4*)(LKT + base_ + 4); \
                C[8] = *(const LAS f32x4*)(LR + base_); C[9] = *(const LAS f32x4*)(LR + base_ + 4); C[10] = *(const LAS f32x4*)(LV + tt_ * 64 + 32 * mem + 4 * rg); } while (0)
#define SC_P(C, q, i) ((f32x2){C[2 * (q) + ((i) >> 1)][2 * ((i) & 1)], C[2 * (q) + ((i) >> 1)][2 * ((i) & 1) + 1]})
#define SC_STEP(C, ST) do { const int tt_ = dir ? 15 - (ST) : (ST); float sa[4], y[4]; f32x2 q_[4]; \
                  \
                _Pragma("unroll") for (int r = 0; r < 4; ++r) q_[r] = S[r][0] * SC_P(C, 0, 0); \
                _Pragma("unroll") for (int i = 1; i < 4; ++i) { _Pragma("unroll") for (int r = 0; r < 4; ++r) q_[r] += S[r][i] * SC_P(C, 0, i); } \
                _Pragma("unroll") for (int r = 0; r < 4; ++r) sa[r] = -(q_[r].x + q_[r].y); \
                red8x4(sa[0], sa[1], sa[2], sa[3]); \
                _Pragma("unroll") for (int i = 0; i < 4; ++i) { f32x2 t_[4]; \
                    _Pragma("unroll") for (int r = 0; r < 4; ++r) t_[r] = S[r][i] * SC_P(C, 1, i); \
                    _Pragma("unroll") for (int r = 0; r < 4; ++r) t_[r] += (f32x2){sa[r], sa[r]} * SC_P(C, 2, i); \
                    _Pragma("unroll") for (int r = 0; r < 4; ++r) t_[r] += (f32x2){C[10][r], C[10][r]} * SC_P(C, 3, i); \
                    _Pragma("unroll") for (int r = 0; r < 4; ++r) { S[r][i] = t_[r]; if (i == 0) q_[r] = t_[r] * SC_P(C, 4, i); else q_[r] += t_[r] * SC_P(C, 4, i); } } \
                if (sy) { _Pragma("unroll") for (int r = 0; r < 4; ++r) y[r] = q_[r].x + q_[r].y; \
                    red8x4(y[0], y[1], y[2], y[3]); \
                    if (kc == 0) *(LAS f32x4*)(YB + tt_ * 64 + 32 * mem + 4 * rg) = (f32x4){y[0], y[1], y[2], y[3]}; } } while (0)
            const bool sy = (J.store_y != 0);
            f32x4 CA[11], CB[11];
            SC_LOAD(CA, 0);
            for (int st = 0; st < 16; st += 2) {
                SC_LOAD(CB, st + 1); asm volatile("" ::: "memory");
                SC_STEP(CA, st);
                if (st + 2 < 16) SC_LOAD(CA, st + 2);
                asm volatile("" ::: "memory");
                SC_STEP(CB, st + 1);
            }
#undef SC_LOAD
#undef SC_P
#undef SC_STEP
        }
        asm volatile("s_waitcnt vmcnt(0)" ::: "memory");
        if (J.store_y) {
            wave_lds_fence();
            const int tq = ln >> 2, pq = ln & 3; const LAS float* yp = YB + tq * 64 + 32 * mem + 8 * pq;
            *(u32x4*)(yout + (size_t)(t0 + tq) * 512 + h * 64 + 32 * mem + 8 * pq) = pack8v(*(const LAS f32x4*)yp, *(const LAS f32x4*)(yp + 4));
        }
        team_bar(bar, bk, lane);
    }
#undef SC_DMA
    if (J.carry) {
#pragma unroll
        for (int r = 0; r < 4; ++r)
#pragma unroll
            for (int j = 0; j < 2; ++j) *(f32x4*)(J.carry + (32 * mem + 4 * (lane >> 3) + r) * 64 + 8 * (lane & 7) + 4 * j) = (f32x4){S[r][2 * j].x, S[r][2 * j].y, S[r][2 * j + 1].x, S[r][2 * j + 1].y};
    }
}
DI void scan_carry_in(int c, int s, int nsc, const float* CU, const float* CP, const int mem, f32x4 (&S)[4][2], LAS float* PT, int lane) {
    const int rg = lane >> 3, kc = lane & 7;
    { const float* U0 = CU + (size_t)(c * nsc) * 4096;
#pragma unroll
      for (int r = 0; r < 4; ++r)
#pragma unroll
          for (int j = 0; j < 2; ++j) S[r][j] = *(const f32x4*)(U0 + (32 * mem + 4 * rg + r) * 64 + 8 * kc + 4 * j); }
    for (int q = 1; q < s; ++q) {
#pragma unroll
        for (int j = 0; j < 2; ++j)
#pragma unroll
            for (int e = 0; e < 4; ++e) *(LAS f32x4*)(PT + (8 * kc + 4 * j + e) * 32 + 4 * rg) = (f32x4){S[0][j][e], S[1][j][e], S[2][j][e], S[3][j][e]};
        wave_lds_fence();
        const float* Pj = CP + (size_t)(c * nsc + q) * 4096; const float* Uj = CU + (size_t)(c * nsc + q) * 4096;
#pragma unroll
        for (int r = 0; r < 4; ++r)
#pragma unroll
            for (int j = 0; j < 2; ++j) S[r][j] = *(const f32x4*)(Uj + (32 * mem + 4 * rg + r) * 64 + 8 * kc + 4 * j);
#pragma unroll 1
        for (int m0 = 0; m0 < 64; m0 += 8) {
            f32x4 pv[8][2];
#pragma unroll
            for (int u = 0; u < 8; ++u)
#pragma unroll
                for (int j = 0; j < 2; ++j) pv[u][j] = *(const f32x4*)(Pj + (m0 + u) * 64 + 8 * kc + 4 * j);
#pragma unroll
            for (int u = 0; u < 8; ++u) {
            const int m = m0 + u;
            const f32x4 sv = *(const LAS f32x4*)(PT + m * 32 + 4 * rg);
#pragma unroll
            for (int j = 0; j < 2; ++j) { const f32x4 p = pv[u][j];
#pragma unroll
                for (int r = 0; r < 4; ++r) S[r][j] += p * sv[r]; }
            }
        }
        wave_lds_fence();
    }
}

DI void post_item(int item, const bf16_t* zrw, const float* convw, const bf16_t* gupT, const bf16_t* yf, const bf16_t* ybk, const float* bonus, const float* lnw, const float* lnb, bf16_t* yb, int lane) {
    asm volatile("" : "+v"(lane));
    const int h = item & 7, tile = item >> 3, tk = lane & 31, hh = lane >> 5; const int t = tile * 32 + tk;
    const int pos = t < TP ? (t & 8191) : (t & 2047), Ls = t < TP ? 8192 : 2048; const bool hp = pos > 0, hn = pos < Ls - 1;
    f32x16 acc[2];
#pragma unroll
    for (int mt = 0; mt < 2; ++mt)
#pragma unroll
        for (int i = 0; i < 16; ++i) acc[mt][i] = 0.f;
#pragma unroll
    for (int ks = 0; ks < 8; ++ks) {
        const int col = 1728 + 16 * ks + 8 * hh; float x[8];
        conv8(zrw, (size_t)t * RWC + col, hp, hn, convw, col, x);
#pragma unroll
        for (int j = 0; j < 8; ++j) x[j] = sigm(x[j]);
        const u32x4 pw = pack8(x); const bf16x8 bfrag = __builtin_bit_cast(bf16x8, pw);
#pragma unroll
        for (int mt = 0; mt < 2; ++mt) {
            const bf16x8 afrag = *(const bf16x8*)(gupT + (size_t)(h * 64 + 32 * mt + tk) * 128 + 16 * ks + 8 * hh);
            acc[mt] = MFMA32(afrag, bfrag, acc[mt]);
        }
    }
    f32x4 y[2][4]; float sum = 0.f;
#pragma unroll
    for (int mt = 0; mt < 2; ++mt)
#pragma unroll
        for (int gi = 0; gi < 4; ++gi) {
            const size_t off = (size_t)t * 512 + h * 64 + 32 * mt + 8 * gi + 4 * hh;
            y[mt][gi] = unpack4(*(const u32x2*)(yf + off)) + unpack4(*(const u32x2*)(ybk + off));
            sum += (y[mt][gi][0] + y[mt][gi][1]) + (y[mt][gi][2] + y[mt][gi][3]);
        }
    sum += __shfl_xor(sum, 32); const float mu = sum * (1.0f / 64.0f); float qv = 0.f;
#pragma unroll
    for (int mt = 0; mt < 2; ++mt)
#pragma unroll
        for (int gi = 0; gi < 4; ++gi) { y[mt][gi] -= mu; const f32x4 s = y[mt][gi] * y[mt][gi]; qv += (s[0] + s[1]) + (s[2] + s[3]); }
    qv += __shfl_xor(qv, 32); const float rs = rsqrtf(qv * (1.0f / 64.0f) + 64e-5f);
    const float bn = bonus[(size_t)t * 8 + h];
#pragma unroll
    for (int mt = 0; mt < 2; ++mt)
#pragma unroll
        for (int gi = 0; gi < 4; ++gi) {
            const int hc = h * 64 + 32 * mt + 8 * gi + 4 * hh;
            const f32x4 v4 = conv4(zrw, (size_t)t * RWC + 1024 + hc, hp, hn, convw, 1024 + hc);
            const f32x4 lw = *(const f32x4*)(lnw + hc), lb = *(const f32x4*)(lnb + hc);
            f32x4 g4;
#pragma unroll
            for (int j = 0; j < 4; ++j) g4[j] = acc[mt][4 * gi + j];
            const f32x4 o = (y[mt][gi] * rs * lw + lb + v4 * bn) * g4;
            *(u32x2*)(yb + (size_t)t * 512 + hc) = pack4v(o);
        }
}
struct Params { const float* in[31]; float* out; unsigned char* ws; int ph_lo, ph_hi; };
constexpr int NPH = 10, NSB = 160;
__global__ void __launch_bounds__(512) mega(Params P) {
    extern __shared__ __attribute__((aligned(16))) unsigned char lds_raw[];
    PG8_LAS unsigned char* lds = (PG8_LAS unsigned char*)lds_raw;
    cg::grid_group grid = cg::this_grid();
    const int wid = __builtin_amdgcn_readfirstlane(threadIdx.x >> 6), b = blockIdx.x, G = gridDim.x;
    unsigned char* ws = P.ws;
    bf16_t *W1T = (bf16_t*)(ws + O_W1T), *W2T = (bf16_t*)(ws + O_W2T), *WpgT = (bf16_t*)(ws + O_WPGT), *WpleT = (bf16_t*)(ws + O_WPLET), *gupT = (bf16_t*)(ws + O_GUPT),
           *wupTf = (bf16_t*)(ws + O_WUPF), *wupTb = (bf16_t*)(ws + O_WUPB), *aupT = (bf16_t*)(ws + O_AUPT), *xb = (bf16_t*)(ws + O_XB), *zrw = (bf16_t*)(ws + O_ZRW),
           *ya = (bf16_t*)(ws + O_YA), *yf = (bf16_t*)(ws + O_YF), *ybk = (bf16_t*)(ws + O_YBK), *yb = (bf16_t*)(ws + O_YB), *Gb = (bf16_t*)(ws + O_G), *MG = (bf16_t*)(ws + O_MG),
           *hid = (bf16_t*)(ws + O_HID), *G7 = (bf16_t*)(ws + O_G7), *pb = (bf16_t*)(ws + O_PB), *WinT = (bf16_t*)(ws + O_WINT), *WgT = (bf16_t*)(ws + O_WGT),
           *WaT = (bf16_t*)(ws + O_WAT), *WbT = (bf16_t*)(ws + O_WBT), *WoT = (bf16_t*)(ws + O_WOT);
    float *rstd1 = (float*)(ws + O_RSTD1), *bonus = (float*)(ws + O_BONUS), *ssq2 = (float*)(ws + O_SSQ2), *ssq3 = (float*)(ws + O_SSQ3);
    unsigned* ctr = (unsigned*)(ws + O_CTR);
    bf16_t *qb = (bf16_t*)P.out, *kb = qb + (size_t)T * 512, *vT = kb + (size_t)T * 512;
    const int lo = P.ph_lo, hi = P.ph_hi;
    XcdBarrier xbar;
    { volatile LAS unsigned* st = (volatile LAS unsigned*)((LAS float*)lds + 34576); int l_; asm volatile("v_mbcnt_lo_u32_b32 %0, -1, 0\n\tv_mbcnt_hi_u32_b32 %0, -1, %0" : "=v"(l_));
      const bool ld_ = (wid == 0 && l_ == 0); if (ld_) { st[0] = 0u; st[1] = 0u; }
      __syncthreads();
      xbar.bar = (unsigned*)(ws + O_BAR); xbar.x = xb_xcc_id(); xbar.st = st; if (ld_) (void)xb_add(&xbar.bar[XB_XCNT(xbar.x)], 1u); }
#define IN(k) (lo <= (k) && (k) < hi)
#define GET_TID() int lane; asm volatile("v_mbcnt_lo_u32_b32 %0, -1, 0\n\tv_mbcnt_hi_u32_b32 %0, -1, %0" : "=v"(lane)); const int tid = wid * 64 + lane; (void)tid
#define GBAR() do { int l_; asm volatile("v_mbcnt_lo_u32_b32 %0, -1, 0\n\tv_mbcnt_hi_u32_b32 %0, -1, %0" : "=v"(l_)); xcd_barrier(xbar, wid == 0 && l_ == 0); } while (0)
#define SEAM(k) do { if (IN(k) && IN((k) + 1)) { if ((k) == 0) grid.sync(); else GBAR(); } } while (0)

    if (IN(0)) {
        GET_TID();
        LAS float* tl = (LAS float*)lds;
        p0_transpose(tl, P.in[5], 5440, 1024, 3584, WinT, P.in[4], 1, 0, G, b, tid);
        p0_transpose(tl, P.in[5], 5440, 1024, 2048, WgT, P.in[4], 0, 3392, G, b, tid);
        p0_transpose(tl, P.in[22], 1024, 512, 1024, WaT, nullptr, 0, 0, G, b, tid);
        p0_transpose(tl, P.in[23], 1024, 512, 1024, WbT, nullptr, 0, 0, G, b, tid);
        p0_transpose(tl, P.in[24], 1024, 1024, 1024, WoT, nullptr, 0, 0, G, b, tid);
        p0_transpose(tl, P.in[26], 4096, 1024, 4096, W1T, P.in[25], 0, 0, G, b, tid);
        p0_transpose(tl, P.in[27], 1024, 4096, 1024, W2T, nullptr, 0, 0, G, b, tid);
        p0_transpose(tl, P.in[30], 1024, 1024, 1024, WpgT, P.in[29], 0, 0, G, b, tid);
        p0_transpose(tl, P.in[28], 1024, 256, 1024, WpleT, nullptr, 0, 0, G, b, tid);
        p0_transpose(tl, P.in[16], 512, 128, 512, gupT, nullptr, 0, 0, G, b, tid);
        p0_transpose(tl, P.in[11], 512, 64, 512, wupTf, nullptr, 0, 0, G, b, tid);
        p0_transpose(tl, P.in[13], 512, 64, 512, wupTb, nullptr, 0, 0, G, b, tid);
        p0_transpose(tl, P.in[15], 512, 64, 512, aupT, nullptr, 0, 0, G, b, tid);
        for (int row0 = b * 8 + wid; row0 < T; row0 += 2 * G * 8) {
            f32x4 v[2][4]; float ss[2];
#pragma unroll
            for (int u = 0; u < 2; ++u) { const int row = row0 + u * G * 8; const float* xr = row < TP ? P.in[0] + (size_t)row * 1024 : P.in[1] + (size_t)(row - TP) * 1024;
#pragma unroll
                for (int j = 0; j < 4; ++j) v[u][j] = *(const f32x4*)(xr + j * 256 + lane * 4); }
#pragma unroll
            for (int u = 0; u < 2; ++u) { const int row = row0 + u * G * 8; ss[u] = 0.f;
#pragma unroll
                for (int j = 0; j < 4; ++j) { const f32x4 s = v[u][j] * v[u][j]; ss[u] += (s[0] + s[1]) + (s[2] + s[3]); }
#pragma unroll
                for (int o = 32; o >= 1; o >>= 1) ss[u] += __shfl_xor(ss[u], o);
#pragma unroll
                for (int j = 0; j < 4; ++j) *(u32x2*)(xb + (size_t)row * 1024 + j * 256 + lane * 4) = pack4v(v[u][j]);
                if (lane == 0) rstd1[row] = rsqrtf(ss[u] * (1.0f / 1024.0f) + 1e-6f); }
        }
        if (b == 0 && tid == 0) ctr[0] = 0u;
    }
    SEAM(0);
    if (IN(1)) {
        GET_TID();
        Gemm g{xb, WinT, T, 3584, 1024}; StaticOrder S; S.init(T, 3584, G, b);
        EpiG1 E{qb, kb, vT, zrw, rstd1, P.in[7], P.in[8]};
        gemm_phase<EpiG1, StaticOrder>(lds, g, S, E, nullptr, tid);
    }
    SEAM(1);
    if (IN(2)) {
        GET_TID();
        ScanArgs SA{zrw, P.in[6], wupTf, wupTb, aupT, P.in[10], P.in[12], P.in[14], P.in[17], P.in[18], P.in[19], bonus, yf, ybk};
        float *CU = (float*)(ws + O_YB), *CP = CU + (size_t)256 * 4096, *CS = CP + (size_t)256 * 4096;
        const int sl = wid % 3, mem = wid / 3;
        LAS float* Lw = (LAS float*)lds + sl * 11520; LAS float* RAWw = Lw + 6144; LAS float* TBw = Lw + 10240;
        f32x4 SI[4][2];
#pragma unroll
        for (int r = 0; r < 4; ++r) { SI[r][0] = (f32x4){0.f, 0.f, 0.f, 0.f}; SI[r][1] = (f32x4){0.f, 0.f, 0.f, 0.f}; }
        LAS unsigned* bars = (LAS unsigned*)((LAS float*)lds + 34560); unsigned bk = 0u;
        if (tid < 3) bars[tid] = 0u;
        __syncthreads();
        {
            const int slot = sl * G + b;
            if (wid < 6 && slot < 672) {
                ScanJob J; J.nst = 1024;
                if (slot < 416) { int c, s, pm; if (slot < 224) { c = slot / 7; s = slot % 7; pm = 0; } else { const int j = slot - 224; c = j / 6; s = 1 + j % 6; pm = 1; }
                    J.tok0 = (c >> 4) * 8192; J.Ls = 8192; J.h = (c >> 1) & 7; J.dir = c & 1; J.seg0 = J.tok0 + (J.dir ? 7 - s : s) * 1024;
                    J.init = pm; J.store_y = (!pm && s == 0) ? 1 : 0; J.carry = (pm ? CP : CU) + (size_t)(c * 8 + s) * 4096; }
                else { const int c = slot - 416; J.tok0 = TP + (c >> 4) * 2048; J.Ls = 2048; J.h = (c >> 1) & 7; J.dir = c & 1; J.seg0 = J.tok0 + (J.dir ? 1 : 0) * 1024; J.init = 0; J.store_y = 1; J.carry = CS + (size_t)c * 4096; }
                scan_team(J, mem, Lw, RAWw, TBw, bars + sl, bk, SI, SA, lane);
            }
            for (;;) {
                unsigned idx = 0; if (lane == 0) idx = atomicAdd(ctr, 1u);
                idx = __builtin_amdgcn_readfirstlane(idx);
                if (idx >= 24576u) break;
                na_item((int)idx, qb, kb, vT, P.in[9], ya, lane);
            }
        }
        GBAR();
        if (tid < 3) bars[tid] = 0u;
        bk = 0u;
        __syncthreads();
        if (b < NSB) {
            const int slot = sl * NSB + b;
            if (wid < 6 && slot < 480) {
                ScanJob J; J.nst = 1024; J.init = 2; J.store_y = 1; J.carry = nullptr;
                LAS float* PTw = Lw + (mem & 1) * 2048;
                if (slot < 224) { const int c = slot / 7, s = 1 + slot % 7; J.tok0 = (c >> 4) * 8192; J.Ls = 8192; J.h = (c >> 1) & 7; J.dir = c & 1; J.seg0 = J.tok0 + (J.dir ? 7 - s : s) * 1024;
                    scan_carry_in(c, s, 8, CU, CP, mem, SI, PTw, lane); }
                else { const int c = slot - 224; J.tok0 = TP + (c >> 4) * 2048; J.Ls = 2048; J.h = (c >> 1) & 7; J.dir = c & 1; J.seg0 = J.tok0 + (J.dir ? 0 : 1) * 1024;
                    scan_carry_in(c, 1, 1, CS, CS, mem, SI, PTw, lane); }
                team_bar(bars + sl, bk, lane);
                scan_team(J, mem, Lw, RAWw, TBw, bars + sl, bk, SI, SA, lane);
            }
        } else {
            Gemm g{xb, WgT, T, 2048, 1024}; StaticOrder S; S.init(T, 2048, G - NSB, b - NSB);
            EpiB<0> E{(bf16_t*)P.out, 2048, rstd1, nullptr, 0};
            gemm_phase<EpiB<0>, StaticOrder>(lds, g, S, E, nullptr, tid);
        }
    }
    SEAM(2);
    if (IN(3)) {
        GET_TID();
        for (int item = b * 8 + wid; item < 12288; item += G * 8) post_item(item, zrw, P.in[6], gupT, yf, ybk, bonus, P.in[20], P.in[21], yb, lane);
    }
    SEAM(3);
    if (IN(4)) {
        GET_TID();
        StaticOrder S; S.init(T, 1024, G, b);
        const bf16_t* G2 = (const bf16_t*)P.out;
        { Gemm g{ya, WaT, T, 1024, 512}; EpiB<1> E{MG, 1024, nullptr, G2, 2048}; gemm_phase<EpiB<1>, StaticOrder>(lds, g, S, E, nullptr, tid); }
        { Gemm g{yb, WbT, T, 1024, 512}; EpiB<2> E{MG, 1024, nullptr, G2 + 1024, 2048}; gemm_phase<EpiB<2>, StaticOrder>(lds, g, S, E, nullptr, tid); }
    }
    SEAM(4);
    if (IN(5)) {
        GET_TID();
        Gemm g{MG, WoT, T, 1024, 1024}; StaticOrder S; S.init(T, 1024, G, b);
        EpiF<0> E{nullptr, nullptr, nullptr, xb, ssq2, nullptr, nullptr};
        gemm_phase<EpiF<0>, StaticOrder>(lds, g, S, E, nullptr, tid);
    }
    SEAM(5);
    if (IN(6)) {
        GET_TID();
        Gemm g{xb, W1T, T, 4096, 1024}; StaticOrder S; S.init(T, 4096, G, b);
        EpiB<3> E{hid, 4096, ssq2, nullptr, 0};
        gemm_phase<EpiB<3>, StaticOrder>(lds, g, S, E, nullptr, tid);
    }
    SEAM(6);
    if (IN(7)) {
        GET_TID();
        Gemm g{hid, W2T, T, 1024, 4096}; StaticOrder S; S.init(T, 1024, G, b);
        EpiF<0> E{nullptr, nullptr, P.out, xb, ssq3, nullptr, nullptr};
        gemm_phase<EpiF<0>, StaticOrder>(lds, g, S, E, nullptr, tid);
    }
    SEAM(7);
    if (IN(8)) {
        GET_TID();
        Gemm g{xb, WpgT, T, 1024, 1024}; StaticOrder S; S.init(T, 1024, G, b);
        EpiF<1> E{nullptr, nullptr, nullptr, G7, nullptr, ssq3, nullptr};
        gemm_phase<EpiF<1>, StaticOrder>(lds, g, S, E, nullptr, tid);
        for (int i = b * 512 + tid; i < T * 32; i += G * 512) {
            const int row = i >> 5, c8 = (i & 31) * 8;
            const float* src = row < TP ? P.in[2] + (size_t)row * 256 + c8 : P.in[3] + (size_t)(row - TP) * 256 + c8;
            *(u32x4*)(pb + (size_t)row * 256 + c8) = pack8v(*(const f32x4*)src, *(const f32x4*)(src + 4));
        }
    }
    SEAM(8);
    if (IN(9)) {
        GET_TID();
        Gemm g{pb, WpleT, T, 1024, 256}; StaticOrder S; S.init(T, 1024, G, b);
        EpiF<2> E{nullptr, nullptr, P.out, G7, nullptr, nullptr, xb};
        gemm_phase<EpiF<2>, StaticOrder>(lds, g, S, E, nullptr, tid);
    }
#undef IN
#undef SEAM
}

extern "C" void kernel_launch(void* const* d_in, const int* in_sizes, int n_in, void* d_out, int out_size, void* d_ws, size_t ws_size, hipStream_t stream) {
    static int grid_blocks = 0;
    if (grid_blocks == 0) {
        if (n_in != 31 || out_size != T * 1024 || ws_size < WS_NEED) { fprintf(stderr, "kernel_launch: unexpected shapes (n_in %d out %d ws %zu)\n", n_in, out_size, ws_size); grid_blocks = -1; return; }
        int dev = 0, cus = 0, per_cu = 0;
        hipGetDevice(&dev); hipDeviceGetAttribute(&cus, hipDeviceAttributeMultiprocessorCount, dev);
        if (hipFuncSetAttribute((const void*)mega, hipFuncAttributeMaxDynamicSharedMemorySize, LDS_BYTES) != hipSuccess) { fprintf(stderr, "kernel_launch: hipFuncSetAttribute failed\n"); grid_blocks = -1; return; }
        hipOccupancyMaxActiveBlocksPerMultiprocessor(&per_cu, (const void*)mega, 512, LDS_BYTES);
        if (per_cu < 1) { fprintf(stderr, "kernel_launch: occupancy query says %d blocks per CU\n", per_cu); grid_blocks = -1; return; }
        grid_blocks = cus;
    }
    if (grid_blocks < 0) return;
    Params p{};
    for (int i = 0; i < 31; ++i) p.in[i] = (const float*)d_in[i];
    p.out = (float*)d_out; p.ws = (unsigned char*)d_ws;
    if (hipMemsetAsync((unsigned char*)d_ws + O_BAR, 0, XCD_BAR_WORDS * 4, stream) != hipSuccess) { fprintf(stderr, "kernel_launch: memset of the barrier words failed\n"); return; }
#if defined(SPLIT_LAUNCH)
    for (int ph = 0; ph < NPH; ++ph) { p.ph_lo = ph; p.ph_hi = ph + 1; hipLaunchKernelGGL(mega, dim3(grid_blocks), dim3(512), LDS_BYTES, stream, p); }
#else
    p.ph_lo = 0; p.ph_hi = NPH;
    void* args[] = {&p};
    hipError_t e = hipLaunchCooperativeKernel((const void*)mega, dim3(grid_blocks), dim3(512), args, LDS_BYTES, stream);
    if (e != hipSuccess) fprintf(stderr, "cooperative launch failed: %s (grid %d)\n", hipGetErrorString(e), grid_blocks);
#endif
}
```

```cpp
#include <hip/hip_runtime.h>
#include <hip/hip_cooperative_groups.h>
#include <cstdio>
namespace pg8 {
#define PG8_LAS __attribute__((address_space(3)))
typedef unsigned short bf16_t;
typedef short bf16x8 __attribute__((ext_vector_type(8)));
typedef float f32x4 __attribute__((ext_vector_type(4)));
typedef unsigned u32x4 __attribute__((ext_vector_type(4)));
constexpr int BM = 256, BK = 64, HALF = 128, HTB = HALF * BK * 2  , STAGE_BYTES = 8 * HTB, NXCD = 8, WGM = 8;

__host__ __device__ __forceinline__ int lds_byte(int r, int c) { const int st = (r >> 4) * 2 + (c >> 5), rr = r & 15, cc = c & 31, ob = rr * 64 + cc * 2; return st * 1024 + (ob ^ (((ob >> 9) & 1) << 5)); }
__host__ __device__ __forceinline__ void stage_rc(int b, int& R, int& C) { const int st = b / 1024, sb = b % 1024, swz = sb ^ (((sb >> 9) & 1) << 5); R = (st >> 1) * 16 + swz / 64; C = (st & 1) * 32 + (swz % 64) / 2; }
__host__ __device__ __forceinline__ int perm32(int rho) { const int n = rho >> 4, i = rho & 15; return 8 * (i >> 2) + 4 * n + (i & 3); }

struct Unit { int pm, pn; };
struct Gemm { const bf16_t* A; const bf16_t* Bt; int M, N, K; };

struct StaticOrder {
    int nM, nN, nwg, G, c;
    __host__ __device__ void init(int M, int N, int G_, int c_) { nM = M / BM; nN = N / BM; nwg = nM * nN; G = G_; c = c_; }
    __host__ __device__ bool next(int i, Unit& u) const {
        const long L = (long)i * G + c; if (L >= nwg) return false;
        int wgid = (int)L; { const int q = nwg / NXCD, r = nwg % NXCD, xcd = wgid % NXCD, off = wgid / NXCD; wgid = (xcd < r ? xcd * (q + 1) : r * (q + 1) + (xcd - r) * q) + off; }
        const int nig = WGM * nN, gid = wgid / nig, fm = gid * WGM, gsz = (nM - fm) < WGM ? (nM - fm) : WGM;
        u.pm = fm + ((wgid % nig) % gsz); u.pn = (wgid % nig) / gsz; return true;
    }
    __device__ __forceinline__ void a_ready(const Unit&) const {}
    __device__ __forceinline__ void done(const Unit&) const {}
};
typedef __bf16 bf16x2v_t __attribute__((ext_vector_type(2)));
typedef float f32x2 __attribute__((ext_vector_type(2)));
__device__ __forceinline__ unsigned cvt_pk_bf16(float lo, float hi) { const f32x2 v = (f32x2){lo, hi}; const bf16x2v_t b = __builtin_convertvector(v, bf16x2v_t); return __builtin_bit_cast(unsigned, b); }
template <class Epi, class Sched, bool STAMP = false>
__device__ __forceinline__ void gemm_phase(PG8_LAS unsigned char* lds, const Gemm g, const Sched& S, const Epi& E, unsigned long long* stamps, const int tid) {
    const int wid = __builtin_amdgcn_readfirstlane(tid >> 6), lane = tid & 63, wr = wid >> 2, wc = wid & 3, fr = lane & 15, fq = lane >> 4;
    const int K = g.K, nt = K / BK;
    int ts_lo = 0, ts_hi = 0, nts = 0; const unsigned long long rt_entry = STAMP ? (unsigned long long)wall_clock64() : 0ull;
#define PG8_STAMP() do { if (STAMP && wid == 0 && nts < 64) { const unsigned long long _c = (unsigned long long)clock64(); \
        ts_lo = (lane == nts) ? (int)(unsigned)_c : ts_lo; ts_hi = (lane == nts) ? (int)(unsigned)(_c >> 32) : ts_hi; ++nts; } } while (0)
    PG8_STAMP();
    unsigned voffA[2], voffB[2];
#pragma unroll
    for (int i = 0; i < 2; ++i) { int R, C; stage_rc(tid * 16 + i * 8192, R, C); const int Rb = Epi::PERM ? ((R & ~31) + perm32(R & 31)) : R;
        voffA[i] = (unsigned)(R * K + C) * 2u; voffB[i] = (unsigned)(Rb * K + C) * 2u; }
    const size_t kstep = (size_t)(BK * 2);
    const size_t hstep = (size_t)HALF * K * 2;
    const size_t tstep = 2 * hstep;
    const unsigned ldsw = (unsigned)wid * 1024u;
    const int aoff = lds_byte(wr * 64 + fr, fq * 8), boff = lds_byte(wc * 32 + fr, fq * 8);
#define PG8_SA(b, h) (((b) * 2 + (h)) * HTB)
#define PG8_SB(b, h) ((4 + (b) * 2 + (h)) * HTB)
#define PG8_STAGE(bufoff, gbase, voff) do { _Pragma("unroll") for (int _i = 0; _i < 2; ++_i) \
        __builtin_amdgcn_global_load_lds((const unsigned*)((const char*)(gbase) + (voff)[_i]), (PG8_LAS unsigned*)(lds + (bufoff) + ldsw + _i * 8192), 16, 0, 0); } while (0)
#define PG8_LDA(dst, b, h) do { _Pragma("unroll") for (int m = 0; m < 4; ++m) _Pragma("unroll") for (int k = 0; k < 2; ++k) dst[m][k] = *(const PG8_LAS bf16x8*)(lds + PG8_SA(b, h) + aoff + m * 2048 + k * 1024); } while (0)
#define PG8_LDB(dst, b, h) do { _Pragma("unroll") for (int n = 0; n < 2; ++n) _Pragma("unroll") for (int k = 0; k < 2; ++k) dst[n][k] = *(const PG8_LAS bf16x8*)(lds + PG8_SB(b, h) + boff + n * 2048 + k * 1024); } while (0)
#define PG8_MMA(ai, bj, At, Bt) do { __builtin_amdgcn_s_setprio(1); _Pragma("unroll") for (int m = 0; m < 4; ++m) _Pragma("unroll") for (int n = 0; n < 2; ++n) _Pragma("unroll") for (int k = 0; k < 2; ++k) \
        acc[ai][bj][m][n] = __builtin_amdgcn_mfma_f32_16x16x32_bf16(Bt[n][k], At[m][k], acc[ai][bj][m][n], 0, 0, 0); __builtin_amdgcn_s_setprio(0); } while (0)
#define PG8_WAIT_V(n) asm volatile("s_waitcnt vmcnt(" #n ")" ::: "memory")
#define PG8_WAIT_L(n) asm volatile("s_waitcnt lgkmcnt(" #n ")" ::: "memory")
#define PG8_BAR __builtin_amdgcn_s_barrier()
#define PG8_SCHED __builtin_amdgcn_sched_barrier(0)
    Unit cur, nxt; int ui = 0;
    if (!S.next(0, cur)) return;
    f32x4 acc[2][2][4][2];
#pragma unroll
    for (int a = 0; a < 2; ++a)
#pragma unroll
        for (int b = 0; b < 2; ++b)
#pragma unroll
            for (int m = 0; m < 4; ++m)
#pragma unroll
                for (int n = 0; n < 2; ++n) acc[a][b][m][n] = (f32x4){0.f, 0.f, 0.f, 0.f};
    bf16x8 At[4][2], B0[2][2], B1[2][2];
    const char* cA = (const char*)g.A + (size_t)cur.pm * tstep; const char* cB = (const char*)g.Bt + (size_t)cur.pn * tstep;
    S.a_ready(cur);
    PG8_STAGE(PG8_SB(0, 0), cB, voffB); PG8_STAGE(PG8_SA(0, 0), cA, voffA); PG8_STAGE(PG8_SB(0, 1), cB + hstep, voffB); PG8_STAGE(PG8_SA(0, 1), cA + hstep, voffA);
    if (wr == 1) PG8_BAR;
    PG8_WAIT_V(4); PG8_BAR;
    PG8_STAGE(PG8_SB(1, 0), cB + kstep, voffB); PG8_STAGE(PG8_SA(1, 0), cA + kstep, voffA); PG8_STAGE(PG8_SB(1, 1), cB + hstep + kstep, voffB);
    PG8_WAIT_V(6); PG8_BAR;
    PG8_STAMP();
    for (;;) {
        const bool has_next = S.next(ui + 1, nxt);
        const char* nA = has_next ? (const char*)g.A + (size_t)nxt.pm * tstep : cA; const char* nB = has_next ? (const char*)g.Bt + (size_t)nxt.pn * tstep : cB;
        for (int t = 0; t < nt; t += 2) {
            const bool last = (t == nt - 2);
            const char* a1 = cA + (size_t)(t + 1) * kstep;
            const char* a2 = last ? nA : cA + (size_t)(t + 2) * kstep; const char* b2 = last ? nB : cB + (size_t)(t + 2) * kstep;
            const char* a3 = a2 + kstep; const char* b3 = b2 + kstep;
            if (last && has_next) S.a_ready(nxt);
            PG8_LDB(B0, 0, 0); PG8_SCHED; PG8_LDA(At, 0, 0); PG8_STAGE(PG8_SA(1, 1), a1 + hstep, voffA);
            PG8_WAIT_L(8); PG8_BAR; PG8_WAIT_L(0); PG8_MMA(0, 0, At, B0); PG8_BAR; PG8_SCHED;
            PG8_LDB(B1, 0, 1); PG8_STAGE(PG8_SB(0, 0), b2, voffB);
            PG8_BAR; PG8_WAIT_L(0); PG8_MMA(0, 1, At, B1); PG8_BAR;
            PG8_LDA(At, 0, 1); PG8_STAGE(PG8_SA(0, 0), a2, voffA);
            PG8_BAR; PG8_WAIT_L(0); PG8_MMA(1, 0, At, B0); PG8_BAR; PG8_SCHED;
            PG8_STAGE(PG8_SB(0, 1), b2 + hstep, voffB);
            PG8_WAIT_V(6); PG8_BAR; PG8_MMA(1, 1, At, B1); PG8_BAR;
            PG8_LDB(B0, 1, 0); PG8_SCHED; PG8_LDA(At, 1, 0); PG8_STAGE(PG8_SA(0, 1), a2 + hstep, voffA);
            PG8_WAIT_L(8); PG8_BAR; PG8_WAIT_L(0); PG8_MMA(0, 0, At, B0); PG8_BAR; PG8_SCHED;
            PG8_LDB(B1, 1, 1); PG8_STAGE(PG8_SB(1, 0), b3, voffB);
            PG8_BAR; PG8_WAIT_L(0); PG8_MMA(0, 1, At, B1); PG8_BAR;
            PG8_LDA(At, 1, 1); PG8_STAGE(PG8_SA(1, 0), a3, voffA);
            PG8_BAR; PG8_WAIT_L(0); PG8_MMA(1, 0, At, B0); PG8_BAR; PG8_SCHED;
            PG8_STAGE(PG8_SB(1, 1), b3 + hstep, voffB);
            PG8_WAIT_V(6); PG8_BAR; PG8_MMA(1, 1, At, B1); PG8_BAR;
        }
        PG8_STAMP();
        if constexpr (!Epi::AFTER_DRAIN) { E(acc, cur, wr, wc, fr, fq); S.done(cur); }
        PG8_STAMP();
        if (!has_next) break;
#pragma unroll
        for (int a = 0; a < 2; ++a)
#pragma unroll
            for (int b = 0; b < 2; ++b)
#pragma unroll
                for (int m = 0; m < 4; ++m)
#pragma unroll
                    for (int n = 0; n < 2; ++n) acc[a][b][m][n] = (f32x4){0.f, 0.f, 0.f, 0.f};
        cur = nxt; cA = nA; cB = nB; ++ui;
    }
    PG8_WAIT_V(0);
    if (wr == 0) PG8_BAR;
    PG8_BAR;
    if constexpr (Epi::AFTER_DRAIN) { E.fused(acc, cur, wr, wc, fr, fq, lds, wid, lane); S.done(cur); }
    PG8_STAMP();
    if (STAMP && wid == 0) { stamps[lane] = lane < nts ? (((unsigned long long)(unsigned)ts_hi << 32) | (unsigned)ts_lo) : 0ull;
        if (lane == 62) stamps[62] = rt_entry; if (lane == 63) stamps[63] = (unsigned long long)wall_clock64(); }
#undef PG8_STAMP
#undef PG8_SA
#undef PG8_SB
#undef PG8_STAGE
#undef PG8_LDA
#undef PG8_LDB
#undef PG8_MMA
#undef PG8_WAIT_V
#undef PG8_WAIT_L
#undef PG8_BAR
#undef PG8_SCHED
}
}
using namespace pg8;
namespace cg = cooperative_groups;
typedef float f32x16 __attribute__((ext_vector_type(16)));
typedef unsigned u32x2 __attribute__((ext_vector_type(2)));
#define LAS __attribute__((address_space(3)))
#define DI __device__ __forceinline__

constexpr int T = 49152, TP = 16384, RWC = 1856;
constexpr size_t MiB = (size_t)1 << 20;
constexpr size_t O_W1T = 0, O_W2T = 8 * MiB, O_WPGT = 16 * MiB, O_WPLET = 18 * MiB, O_GUPT = 18 * MiB + 512 * 1024, O_WUPF = O_GUPT + 128 * 1024,
    O_WUPB = O_WUPF + 64 * 1024, O_AUPT = O_WUPB + 64 * 1024, O_RSTD1 = 19 * MiB, O_BONUS = 19 * MiB + 256 * 1024, O_SSQ2 = 21 * MiB, O_SSQ3 = 24 * MiB,
    O_CTR = 27 * MiB, O_BAR = 27 * MiB + 4096, O_CARU = 28 * MiB, O_CARP = 30 * MiB, O_XB = 32 * MiB, O_ZRW = 128 * MiB, O_YA = 302 * MiB, O_YF = 350 * MiB, O_YBK = 398 * MiB, O_YB = 446 * MiB, O_G = 128 * MiB,
    O_MG = 350 * MiB, O_HID = 128 * MiB, O_G7 = 128 * MiB, O_PB = 224 * MiB, O_WINT = 496 * MiB, O_WGT = 503 * MiB, O_WAT = 507 * MiB, O_WBT = 508 * MiB,
    O_WOT = 509 * MiB, WS_NEED = 512 * MiB;
constexpr int LDS_BYTES = 3 * 11520 * 4 + 128;

DI float bflo(unsigned u) { return __uint_as_float(u << 16); }
DI float bfhi(unsigned u) { return __uint_as_float(u & 0xffff0000u); }
DI float sigm(float x) { return __builtin_amdgcn_rcpf(1.0f + __expf(-x)); }
DI u32x4 pack8(const float* f) { u32x4 w; w.x = cvt_pk_bf16(f[0], f[1]); w.y = cvt_pk_bf16(f[2], f[3]); w.z = cvt_pk_bf16(f[4], f[5]); w.w = cvt_pk_bf16(f[6], f[7]); return w; }
DI u32x4 pack8v(f32x4 a, f32x4 b) { u32x4 w; w.x = cvt_pk_bf16(a[0], a[1]); w.y = cvt_pk_bf16(a[2], a[3]); w.z = cvt_pk_bf16(b[0], b[1]); w.w = cvt_pk_bf16(b[2], b[3]); return w; }
DI u32x2 pack4v(f32x4 a) { u32x2 w; w.x = cvt_pk_bf16(a[0], a[1]); w.y = cvt_pk_bf16(a[2], a[3]); return w; }
DI void unpack8(u32x4 w, f32x4& a, f32x4& b) { a = (f32x4){bflo(w.x), bfhi(w.x), bflo(w.y), bfhi(w.y)}; b = (f32x4){bflo(w.z), bfhi(w.z), bflo(w.w), bfhi(w.w)}; }
DI f32x4 unpack4(u32x2 w) { return (f32x4){bflo(w.x), bfhi(w.x), bflo(w.y), bfhi(w.y)}; }
DI float dpp_xor1(float x) { return __int_as_float(__builtin_amdgcn_mov_dpp(__float_as_int(x), 0xB1, 0xF, 0xF, true)); }
DI float dpp_xor2(float x) { return __int_as_float(__builtin_amdgcn_mov_dpp(__float_as_int(x), 0x4E, 0xF, 0xF, true)); }
DI void wave_lds_fence() { asm volatile("s_waitcnt lgkmcnt(0)" ::: "memory"); __builtin_amdgcn_wave_barrier(); }
#define MFMA32(a, b, c) __builtin_amdgcn_mfma_f32_32x32x16_bf16((a), (b), (c), 0, 0, 0)
#define MFMA16(a, b, c) __builtin_amdgcn_mfma_f32_16x16x32_bf16((a), (b), (c), 0, 0, 0)


#define XB_TMO      128
#define XB_XCNT(j)  (256  + 64 * (j))
#define XB_XSUB(j)  (1280 + 64 * (j))
#define XB_XGEN(j)  (2304 + 64 * (j))
#define XB_TOP      3328
#define XB_TOPGEN   3392
#define XCD_BAR_WORDS 3456
#define XB_SPIN_CAP (1u << 20)
DI unsigned xb_ld(unsigned* p)              { return __hip_atomic_load(p, __ATOMIC_RELAXED, __HIP_MEMORY_SCOPE_AGENT); }
DI unsigned xb_add(unsigned* p, unsigned v) { return __hip_atomic_fetch_add(p, v, __ATOMIC_RELAXED, __HIP_MEMORY_SCOPE_AGENT); }
DI unsigned xb_xcc_id() { return (unsigned)__builtin_amdgcn_s_getreg((3 << 11) | 20) & 0xFu; }
#define XB_SPIN(cond, bar) do { unsigned _sp = 0; while (cond) { __builtin_amdgcn_s_sleep(1); \
    if ((++_sp & 255u) == 0u) { if (xb_ld(&(bar)[XB_TMO])) break; if (_sp > XB_SPIN_CAP) { atomicAdd(&(bar)[XB_TMO], 1u); break; } } } } while (0)
struct XcdBarrier { unsigned* bar; unsigned x; volatile LAS unsigned* st; };
DI void xcd_barrier_complete(unsigned* bar, unsigned x, unsigned& nloc, unsigned& nx) {
    const unsigned G = gridDim.x;
    unsigned sum, cnt, mine, sp = 0u;
    for (;;) {
        sum = 0u; cnt = 0u; mine = 0u;
#pragma unroll
        for (unsigned j = 0; j < 16; ++j) { const unsigned c = xb_ld(&bar[XB_XCNT(j)]); sum += c; cnt += (c > 0u) ? 1u : 0u; mine = (j == x) ? c : mine; }
        if (sum == G) break;
        __builtin_amdgcn_s_sleep(1);
        if ((++sp & 255u) == 0u) { if (xb_ld(&bar[XB_TMO])) break; if (sp > XB_SPIN_CAP) { atomicAdd(&bar[XB_TMO], 1u); break; } }
    }
    nloc = mine > 0u ? mine : 1u; nx = cnt > 0u ? cnt : 1u;
}
DI void xcd_barrier(const XcdBarrier& b, const bool leader) {
    asm volatile("s_waitcnt vmcnt(0)" ::: "memory");
    __syncthreads();
    if (leader) {
        unsigned* bar = b.bar;
        __builtin_amdgcn_s_waitcnt(0);
        unsigned nloc = b.st[0], nx = b.st[1];
        if (nloc == 0u) { xcd_barrier_complete(bar, b.x, nloc, nx); b.st[0] = nloc; b.st[1] = nx; }
        const unsigned old = xb_add(&bar[XB_XSUB(b.x)], 1u);
        const unsigned gen = old / nloc;
        if (old + 1u == (gen + 1u) * nloc) {
            __builtin_amdgcn_fence(__ATOMIC_RELEASE, "agent");
            asm volatile("s_waitcnt vmcnt(0)" ::: "memory");
            const unsigned og = xb_add(&bar[XB_TOP], 1u);
            const unsigned tg = og / nx;
            if (og + 1u == (tg + 1u) * nx) xb_add(&bar[XB_TOPGEN], 1u);
            else XB_SPIN(xb_ld(&bar[XB_TOPGEN]) == tg, bar);
            __builtin_amdgcn_fence(__ATOMIC_ACQUIRE, "agent");
            xb_add(&bar[XB_XGEN(b.x)], 1u);
            asm volatile("s_waitcnt vmcnt(0)" ::: "memory");
        } else {
            XB_SPIN(xb_ld(&bar[XB_XGEN(b.x)]) == gen, bar);
            __builtin_amdgcn_fence(__ATOMIC_ACQUIRE, "agent");
            asm volatile("s_waitcnt vmcnt(0)" ::: "memory");
        }
    }
    __syncthreads();
}
DI void conv8(const bf16_t* z, size_t rowoff, bool hp, bool hn, const float* cw, int col, float* out) {
    const u32x4 zz = (u32x4){0u, 0u, 0u, 0u};
    const u32x4 a = hp ? *(const u32x4*)(z + rowoff - RWC) : zz;
    const u32x4 b = *(const u32x4*)(z + rowoff);
    const u32x4 c = hn ? *(const u32x4*)(z + rowoff + RWC) : zz;
    const f32x4 w0a = *(const f32x4*)(cw + col), w0b = *(const f32x4*)(cw + col + 4);
    const f32x4 w1a = *(const f32x4*)(cw + RWC + col), w1b = *(const f32x4*)(cw + RWC + col + 4);
    const f32x4 w2a = *(const f32x4*)(cw + 2 * RWC + col), w2b = *(const f32x4*)(cw + 2 * RWC + col + 4);
    f32x4 a0, a1, b0, b1, c0, c1; unpack8(a, a0, a1); unpack8(b, b0, b1); unpack8(c, c0, c1);
    const f32x4 o0 = a0 * w0a + b0 * w1a + c0 * w2a, o1 = a1 * w0b + b1 * w1b + c1 * w2b;
#pragma unroll
    for (int j = 0; j < 4; ++j) { out[j] = o0[j]; out[4 + j] = o1[j]; }
}
DI f32x4 conv4(const bf16_t* z, size_t rowoff, bool hp, bool hn, const float* cw, int col) {
    const u32x2 zz = (u32x2){0u, 0u};
    const u32x2 a = hp ? *(const u32x2*)(z + rowoff - RWC) : zz;
    const u32x2 b = *(const u32x2*)(z + rowoff);
    const u32x2 c = hn ? *(const u32x2*)(z + rowoff + RWC) : zz;
    return unpack4(a) * *(const f32x4*)(cw + col) + unpack4(b) * *(const f32x4*)(cw + RWC + col) + unpack4(c) * *(const f32x4*)(cw + 2 * RWC + col);
}

struct EpiG1 {
    static constexpr bool PERM = true, AFTER_DRAIN = false;
    bf16_t *q, *k, *vT, *zrw; const float *rstd, *qg, *kg;
    __device__ __forceinline__ void operator()(const f32x4 (&acc)[2][2][4][2], const Unit& u, int wr, int wc, int fr, int fq) const {
        const int row0 = u.pm * BM + wr * 64 + fr;
        float rsv[2][4];
#pragma unroll
        for (int ai = 0; ai < 2; ++ai)
#pragma unroll
            for (int m = 0; m < 4; ++m) rsv[ai][m] = rstd[row0 + ai * HALF + m * 16];
        if (u.pn < 6) {
            const int kind = u.pn >> 1, head = 4 * (u.pn & 1) + wc;
            if (kind < 2) {
                bf16_t* dst = kind ? k : q; const float* gn = kind ? kg : qg;
                f32x4 g0[2][2];
#pragma unroll
                for (int bj = 0; bj < 2; ++bj)
#pragma unroll
                    for (int n = 0; n < 2; ++n) g0[bj][n] = *(const f32x4*)(gn + 32 * bj + 8 * fq + 4 * n);
#pragma unroll
                for (int ai = 0; ai < 2; ++ai)
#pragma unroll
                    for (int m = 0; m < 4; ++m) {
                        const int row = row0 + ai * HALF + m * 16; const float rs = rsv[ai][m];
                        f32x4 v[2][2]; float ss = 0.f;
#pragma unroll
                        for (int bj = 0; bj < 2; ++bj)
#pragma unroll
                            for (int n = 0; n < 2; ++n) { v[bj][n] = acc[ai][bj][m][n] * rs; const f32x4 s = v[bj][n] * v[bj][n]; ss += (s[0] + s[1]) + (s[2] + s[3]); }
                        ss += __shfl_xor(ss, 16); ss += __shfl_xor(ss, 32);
                        const float sc = rsqrtf(ss * (1.0f / 64.0f) + 1e-6f);
#pragma unroll
                        for (int bj = 0; bj < 2; ++bj)
                            *(u32x4*)(dst + (size_t)row * 512 + head * 64 + 32 * bj + 8 * fq) = pack8v(v[bj][0] * sc * g0[bj][0], v[bj][1] * sc * g0[bj][1]);
                    }
            } else {
#pragma unroll
                for (int ai = 0; ai < 2; ++ai)
#pragma unroll
                    for (int m = 0; m < 4; ++m) {
                        const int row = row0 + ai * HALF + m * 16; const float rs = rsv[ai][m];
#pragma unroll
                        for (int bj = 0; bj < 2; ++bj)
#pragma unroll
                            for (int n = 0; n < 2; ++n) {
                                const f32x4 v = acc[ai][bj][m][n] * rs; const unsigned p0 = cvt_pk_bf16(v[0], v[1]), p1 = cvt_pk_bf16(v[2], v[3]);
                                bf16_t* d = vT + (size_t)(head * 64 + 32 * bj + 8 * fq + 4 * n) * T + row;
                                d[0] = (bf16_t)(p0 & 0xffffu); d[T] = (bf16_t)(p0 >> 16); d[2 * (size_t)T] = (bf16_t)(p1 & 0xffffu); d[3 * (size_t)T] = (bf16_t)(p1 >> 16);
                            }
                    }
            }
        } else {
            const int col0 = (u.pn - 6) * BM + wc * 32 + 8 * fq;
#pragma unroll
            for (int ai = 0; ai < 2; ++ai)
#pragma unroll
                for (int m = 0; m < 4; ++m) {
                    const int row = row0 + ai * HALF + m * 16; const float rs = rsv[ai][m];
#pragma unroll
                    for (int bj = 0; bj < 2; ++bj) { const int col = col0 + bj * HALF;
                        if (col < RWC) *(u32x4*)(zrw + (size_t)row * RWC + col) = pack8v(acc[ai][bj][m][0] * rs, acc[ai][bj][m][1] * rs); }
                }
        }
    }
};
template <int MODE> struct EpiB {
    static constexpr bool PERM = true, AFTER_DRAIN = false;
    bf16_t* O; int ld; const float* rs; const bf16_t* G; int ldg;
    __device__ __forceinline__ void operator()(const f32x4 (&acc)[2][2][4][2], const Unit& u, int wr, int wc, int fr, int fq) const {
        const int row0 = u.pm * BM + wr * 64 + fr, col0 = u.pn * BM + wc * 32 + 8 * fq;
        float rr[2][4];
#pragma unroll
        for (int ai = 0; ai < 2; ++ai)
#pragma unroll
            for (int m = 0; m < 4; ++m) {
                const int row = row0 + ai * HALF + m * 16; rr[ai][m] = 1.f;
                if (MODE == 0) rr[ai][m] = rs[row];
                if (MODE == 3) { const f32x4* p = (const f32x4*)(rs + (size_t)row * 16); const f32x4 s = (p[0] + p[1]) + (p[2] + p[3]); rr[ai][m] = rsqrtf(((s[0] + s[1]) + (s[2] + s[3])) * (1.0f / 1024.0f) + 1e-6f); }
            }
#pragma unroll
        for (int ai = 0; ai < 2; ++ai)
#pragma unroll
            for (int mh = 0; mh < 2; ++mh) {
                u32x4 gq[2][2], oq[2][2];
                if (MODE == 1 || MODE == 2) {
#pragma unroll
                    for (int mm = 0; mm < 2; ++mm)
#pragma unroll
                        for (int bj = 0; bj < 2; ++bj) { const int row = row0 + ai * HALF + (2 * mh + mm) * 16;
                            gq[mm][bj] = *(const u32x4*)(G + (size_t)row * ldg + col0 + bj * HALF);
                            if (MODE == 2) oq[mm][bj] = *(const u32x4*)(O + (size_t)row * ld + col0 + bj * HALF); }
                }
#pragma unroll
                for (int mm = 0; mm < 2; ++mm)
#pragma unroll
                    for (int bj = 0; bj < 2; ++bj) {
                        const int m = 2 * mh + mm, row = row0 + ai * HALF + m * 16; const float r = rr[ai][m];
                        const size_t off = (size_t)row * ld + col0 + bj * HALF;
                        f32x4 v0 = acc[ai][bj][m][0], v1 = acc[ai][bj][m][1];
                        if (MODE == 0) {
#pragma unroll
                            for (int j = 0; j < 4; ++j) { v0[j] = sigm(v0[j] * r); v1[j] = sigm(v1[j] * r); } }
                        if (MODE == 1 || MODE == 2) { f32x4 g0, g1; unpack8(gq[mm][bj], g0, g1); v0 *= g0; v1 *= g1; }
                        if (MODE == 2) { f32x4 m0, m1; unpack8(oq[mm][bj], m0, m1); v0 += m0; v1 += m1; }
                        if (MODE == 3) {
#pragma unroll
                            for (int j = 0; j < 4; ++j) { const float a_ = fmaxf(v0[j] * r, 0.f), b_ = fmaxf(v1[j] * r, 0.f); v0[j] = a_ * a_; v1[j] = b_ * b_; } }
                        *(u32x4*)(O + off) = pack8v(v0, v1);
                    }
            }
    }
};
template <int MODE> struct EpiF {
    static constexpr bool PERM = false, AFTER_DRAIN = false;
    const float* resP; const float* resS; float* out; bf16_t* hb; float* ssq; const float* ssin; const bf16_t* r16;
    __device__ __forceinline__ void operator()(const f32x4 (&acc)[2][2][4][2], const Unit& u, int wr, int wc, int fr, int fq) const {
        const int row0 = u.pm * BM + wr * 64 + fr, col0 = u.pn * BM + wc * 32 + 4 * fq;
        float rr[2][4];
#pragma unroll
        for (int ai = 0; ai < 2; ++ai)
#pragma unroll
            for (int m = 0; m < 4; ++m) { rr[ai][m] = 1.f;
                if (MODE == 1) { const int row = row0 + ai * HALF + m * 16; const f32x4* p = (const f32x4*)(ssin + (size_t)row * 16); const f32x4 s = (p[0] + p[1]) + (p[2] + p[3]); rr[ai][m] = rsqrtf(((s[0] + s[1]) + (s[2] + s[3])) * (1.0f / 1024.0f) + 1e-6f); } }
#pragma unroll
        for (int ai = 0; ai < 2; ++ai)
#pragma unroll
            for (int mh = 0; mh < 2; ++mh) {
                u32x2 hq[2][2][2]; f32x4 oq[2][2][2];
                if (MODE == 0 || MODE == 2) {
#pragma unroll
                    for (int mm = 0; mm < 2; ++mm)
#pragma unroll
                        for (int bj = 0; bj < 2; ++bj)
#pragma unroll
                            for (int n = 0; n < 2; ++n) { const size_t off = (size_t)(row0 + ai * HALF + (2 * mh + mm) * 16) * 1024 + col0 + bj * HALF + n * 16;
                                hq[mm][bj][n] = *(const u32x2*)(hb + off); if (MODE == 2) oq[mm][bj][n] = *(const f32x4*)(out + off); }
                }
#pragma unroll
                for (int mm = 0; mm < 2; ++mm) {
                    const int m = 2 * mh + mm, row = row0 + ai * HALF + m * 16; const float r = rr[ai][m]; float ssl = 0.f;
#pragma unroll
                    for (int bj = 0; bj < 2; ++bj)
#pragma unroll
                        for (int n = 0; n < 2; ++n) {
                            const int col = col0 + bj * HALF + n * 16; const size_t off = (size_t)row * 1024 + col;
                            f32x4 v = acc[ai][bj][m][n];
                            if (MODE == 0) { v += unpack4(hq[mm][bj][n]); if (out) *(f32x4*)(out + off) = v;
                                *(u32x2*)(hb + off) = pack4v(v); const f32x4 s = v * v; ssl += (s[0] + s[1]) + (s[2] + s[3]); }
                            if (MODE == 1) {
#pragma unroll
                                for (int j = 0; j < 4; ++j) v[j] = sigm(v[j] * r);
                                *(u32x2*)(hb + off) = pack4v(v); }
                            if (MODE == 2) { const f32x4 g = unpack4(hq[mm][bj][n]); *(f32x4*)(out + off) = oq[mm][bj][n] + g * v; }
                        }
                    if (MODE == 0) { ssl += __shfl_xor(ssl, 16); ssl += __shfl_xor(ssl, 32); if (fq == 0) ssq[(size_t)row * 16 + u.pn * 4 + wc] = ssl; }
                }
            }
    }
};
DI void p0_tile_load(const float* W, int ldw, const float* gs, int mode, int col0, int tk, int tn, int tid, f32x4 (&v)[2]) {
#pragma unroll
    for (int i = 0; i < 2; ++i) {
        const int kk = (tid >> 4) + 32 * i, n = tn * 64 + (tid & 15) * 4; int col = col0 + n;
        if (mode == 1) { if (n < 1536) { const int pn = n >> 8, j = n & 255; col = 256 * pn + 64 * ((j >> 5) & 3) + 32 * (j >> 7) + (j & 31); } else if (n >= 3392) col = -1; }
        v[i] = (f32x4){0.f, 0.f, 0.f, 0.f};
        if (col >= 0) v[i] = *(const f32x4*)(W + (size_t)(tk * 64 + kk) * ldw + col);
        if (gs) v[i] *= gs[tk * 64 + kk];
    }
}
DI void p0_transpose(LAS float* tl, const float* W, int ldw, int K, int Nrows, bf16_t* dst, const float* gs, int mode, int col0, int G, int b, int tid) {
    const int ntk = K / 64, ntn = Nrows / 64, nt = ntk * ntn;
    f32x4 v[2], vn[2];
    if (b < nt) p0_tile_load(W, ldw, gs, mode, col0, b % ntk, b / ntk, tid, v);
    for (int tile = b; tile < nt; tile += G) {
        const int tk = tile % ntk, tn = tile / ntk;
#pragma unroll
        for (int i = 0; i < 2; ++i) { const int kk = (tid >> 4) + 32 * i;
#pragma unroll
            for (int j = 0; j < 4; ++j) tl[kk * 65 + (tid & 15) * 4 + j] = v[i][j]; }
        const int nx = tile + G;
        if (nx < nt) p0_tile_load(W, ldw, gs, mode, col0, nx % ntk, nx / ntk, tid, vn);
        __syncthreads();
        { const int n = tid >> 3, k8 = (tid & 7) * 8; float f[8];
#pragma unroll
          for (int j = 0; j < 8; ++j) f[j] = tl[(k8 + j) * 65 + n];
          *(u32x4*)(dst + (size_t)(tn * 64 + n) * K + tk * 64 + k8) = pack8(f); }
        __syncthreads();
        v[0] = vn[0]; v[1] = vn[1];
    }
}

DI void na_item(int item, const bf16_t* q, const bf16_t* k, const bf16_t* vT, const float* relb, bf16_t* ya, int lane) {
    asm volatile("" : "+v"(lane));
    const int cb = item & 3, h = (item >> 2) & 7, pr = item >> 5;
    const int rows = pr < 256 ? 128 : 32;
    const int r = pr < 256 ? (pr & 127) : ((pr - 256) & 31);
    const int rs0 = min(max(r - 4, 0), rows - 8);
    const int prbase = pr - r + rs0;
    const int blk = min(max(cb * 16 - 8, 0), 32);
    const int l16 = lane & 15, g = lane >> 4;
    const bf16_t* qp = q + (size_t)(pr * 64 + cb * 16 + l16) * 512 + h * 64 + 8 * g;
    const bf16x8 qf0 = *(const bf16x8*)qp, qf1 = *(const bf16x8*)(qp + 32);
    f32x4 sc[8][2];
#pragma unroll
    for (int s = 0; s < 8; ++s)
#pragma unroll
        for (int u = 0; u < 2; ++u) {
            const int tok = (prbase + s) * 64 + blk + 8 * (l16 >> 2) + 4 * u + (l16 & 3);
            const bf16_t* kp = k + (size_t)tok * 512 + h * 64 + 8 * g;
            const bf16x8 kf0 = *(const bf16x8*)kp, kf1 = *(const bf16x8*)(kp + 32);
            f32x4 a = (f32x4){0.f, 0.f, 0.f, 0.f};
            a = MFMA16(kf0, qf0, a); a = MFMA16(kf1, qf1, a);
            sc[s][u] = a;
            if (u == 1 && (s & 1)) asm volatile("" ::: "memory");
        }
    const int qc = cb * 16 + l16, cs = min(max(qc - 8, 0), 48);
    const float* rb = relb + h * 465;
    float mx = -3.0e38f;
#pragma unroll
    for (int s = 0; s < 8; ++s) {
        const int dr = rs0 + s - r + 7;
#pragma unroll
        for (int u = 0; u < 2; ++u)
#pragma unroll
            for (int j = 0; j < 4; ++j) {
                const int kc = blk + 8 * g + 4 * u + j; const bool valid = (kc >= cs) && (kc < cs + 16);
                const int dc = min(max(kc - qc + 15, 0), 30);
                float v = sc[s][u][j] * 0.125f + rb[dr * 31 + dc];
                v = valid ? v : -1.0e30f; sc[s][u][j] = v; mx = fmaxf(mx, v);
            }
    }
    mx = fmaxf(mx, __shfl_xor(mx, 16)); mx = fmaxf(mx, __shfl_xor(mx, 32));
    float sum = 0.f;
#pragma unroll
    for (int s = 0; s < 8; ++s)
#pragma unroll
        for (int u = 0; u < 2; ++u)
#pragma unroll
            for (int j = 0; j < 4; ++j) { const float p = __expf(sc[s][u][j] - mx); sc[s][u][j] = p; sum += p; }
    sum += __shfl_xor(sum, 16); sum += __shfl_xor(sum, 32);
    const float inv = 1.0f / sum;
    f32x4 o[4];
#pragma unroll
    for (int dt = 0; dt < 4; ++dt) o[dt] = (f32x4){0.f, 0.f, 0.f, 0.f};
#pragma unroll
    for (int s = 0; s < 8; ++s) {
        const u32x4 pw = pack8v(sc[s][0] * inv, sc[s][1] * inv); const bf16x8 pa = __builtin_bit_cast(bf16x8, pw);
#pragma unroll
        for (int dt = 0; dt < 4; ++dt) {
            const bf16x8 vf = *(const bf16x8*)(vT + (size_t)(h * 64 + 16 * dt + l16) * T + (prbase + s) * 64 + blk + 8 * g);
            o[dt] = MFMA16(pa, vf, o[dt]);
        }
        if (s & 1) asm volatile("" ::: "memory");
    }
#pragma unroll
    for (int dt = 0; dt < 4; ++dt)
#pragma unroll
        for (int j = 0; j < 4; ++j) {
            const unsigned p = cvt_pk_bf16(o[dt][j], 0.f);
            ya[(size_t)(pr * 64 + cb * 16 + 4 * g + j) * 512 + h * 64 + 16 * dt + l16] = (bf16_t)(p & 0xffffu);
        }
}

struct ScanArgs { const bf16_t* zrw; const float* convw; const bf16_t *wupTf, *wupTb, *aupT; const float *w0f, *w0b, *a0, *k_k, *k_a, *r_k; float* bonus; bf16_t *yf, *ybk; };
struct ScanJob { int tok0, Ls, seg0, nst, h, dir, init, store_y; float* carry; };
DI float red8(float x) {
    x += dpp_xor1(x); x += dpp_xor2(x);
    x += __int_as_float(__builtin_amdgcn_mov_dpp(__float_as_int(x), 0x141, 0xF, 0xF, true));
    return x;
}
DI void red8x4(float& a, float& b, float& c, float& d) {
    asm volatile("s_nop 1\n\t"
                 "v_add_f32_dpp %0, %0, %0 quad_perm:[1,0,3,2] row_mask:0xf bank_mask:0xf bound_ctrl:1\n\t"
                 "v_add_f32_dpp %1, %1, %1 quad_perm:[1,0,3,2] row_mask:0xf bank_mask:0xf bound_ctrl:1\n\t"
                 "v_add_f32_dpp %2, %2, %2 quad_perm:[1,0,3,2] row_mask:0xf bank_mask:0xf bound_ctrl:1\n\t"
                 "v_add_f32_dpp %3, %3, %3 quad_perm:[1,0,3,2] row_mask:0xf bank_mask:0xf bound_ctrl:1\n\t"
                 "v_add_f32_dpp %0, %0, %0 quad_perm:[2,3,0,1] row_mask:0xf bank_mask:0xf bound_ctrl:1\n\t"
                 "v_add_f32_dpp %1, %1, %1 quad_perm:[2,3,0,1] row_mask:0xf bank_mask:0xf bound_ctrl:1\n\t"
                 "v_add_f32_dpp %2, %2, %2 quad_perm:[2,3,0,1] row_mask:0xf bank_mask:0xf bound_ctrl:1\n\t"
                 "v_add_f32_dpp %3, %3, %3 quad_perm:[2,3,0,1] row_mask:0xf bank_mask:0xf bound_ctrl:1\n\t"
                 "v_add_f32_dpp %0, %0, %0 row_half_mirror row_mask:0xf bank_mask:0xf bound_ctrl:1\n\t"
                 "v_add_f32_dpp %1, %1, %1 row_half_mirror row_mask:0xf bank_mask:0xf bound_ctrl:1\n\t"
                 "v_add_f32_dpp %2, %2, %2 row_half_mirror row_mask:0xf bank_mask:0xf bound_ctrl:1\n\t"
                 "v_add_f32_dpp %3, %3, %3 row_half_mirror row_mask:0xf bank_mask:0xf bound_ctrl:1"
                 : "+v"(a), "+v"(b), "+v"(c), "+v"(d));
}
DI void team_bar(LAS unsigned* bar, unsigned& k, int lane) {
    asm volatile("s_waitcnt lgkmcnt(0)" ::: "memory");
    k += 2u;
    if (lane == 0) __hip_atomic_fetch_add(bar, 1u, __ATOMIC_RELAXED, __HIP_MEMORY_SCOPE_WORKGROUP);
    while (__hip_atomic_load(bar, __ATOMIC_RELAXED, __HIP_MEMORY_SCOPE_WORKGROUP) < k) __builtin_amdgcn_s_sleep(1);
    asm volatile("s_waitcnt lgkmcnt(0)" ::: "memory");
}
DI void conv8R(const LAS float* raw, int rr, int pc, bool hp, bool hn, const LAS float* cw, float* out) {
    const u32x4 zz = (u32x4){0u, 0u, 0u, 0u};
    u32x4 a = *(const LAS u32x4*)(raw + (rr * 40 + pc) * 4); const u32x4 b = *(const LAS u32x4*)(raw + ((rr + 1) * 40 + pc) * 4); u32x4 c = *(const LAS u32x4*)(raw + ((rr + 2) * 40 + pc) * 4);
    a = hp ? a : zz; c = hn ? c : zz;
    const f32x4 w0a = *(const LAS f32x4*)(cw), w0b = *(const LAS f32x4*)(cw + 4), w1a = *(const LAS f32x4*)(cw + 64), w1b = *(const LAS f32x4*)(cw + 68), w2a = *(const LAS f32x4*)(cw + 128), w2b = *(const LAS f32x4*)(cw + 132);
    f32x4 a0, a1, b0, b1, c0, c1; unpack8(a, a0, a1); unpack8(b, b0, b1); unpack8(c, c0, c1);
    const f32x4 o0 = a0 * w0a + b0 * w1a + c0 * w2a, o1 = a1 * w0b + b1 * w1b + c1 * w2b;
#pragma unroll
    for (int j = 0; j < 4; ++j) { out[j] = o0[j]; out[4 + j] = o1[j]; }
}
DI void scan_team(const ScanJob J, const int mem, LAS float* L, LAS float* RAW, LAS float* TB, LAS unsigned* bar, unsigned& bk, f32x4 (&SI)[4][2], const ScanArgs& A, int lane) {
    const int tok0 = J.tok0, Ls = J.Ls, h = J.h, dir = J.dir; const bool pmode = (J.init == 1);
    LAS float *LW = L, *LKK = L + 1024, *LB = L + 2048, *LKT = L + 3072, *LR = L + 4096, *LV = L + 5120;
    LAS float* YB = L + 9216;
    const bf16_t* wupT = dir ? A.wupTb : A.wupTf; const float* w0 = dir ? A.w0b : A.w0f; bf16_t* yout = dir ? A.ybk : A.yf;
    const int dwcol = 1536 + 64 * dir;
#pragma unroll
    for (int tap = 0; tap < 3; ++tap) {
#pragma unroll
        for (int vec = 0; vec < 3; ++vec) TB[(vec * 3 + tap) * 64 + lane] = A.convw[tap * RWC + vec * 512 + h * 64 + lane];
        TB[576 + tap * 64 + lane] = A.convw[tap * RWC + dwcol + lane];
        TB[576 + 192 + tap * 64 + lane] = A.convw[tap * RWC + 1664 + lane];
    }
    TB[960 + lane] = A.k_k[h * 64 + lane]; TB[1024 + lane] = A.k_a[h * 64 + lane]; TB[1088 + lane] = A.r_k[h * 64 + lane];
    TB[1152 + lane] = w0[h * 64 + lane]; TB[1216 + lane] = A.a0[h * 64 + lane];
    f32x2 S[4][4];
#pragma unroll
    for (int r = 0; r < 4; ++r)
#pragma unroll
        for (int j = 0; j < 2; ++j) { f32x4 z = SI[r][j];
            if (J.init != 2) {
#pragma unroll
                for (int e = 0; e < 4; ++e) z[e] = (pmode && (32 * mem + 4 * (lane >> 3) + r == 8 * (lane & 7) + 4 * j + e)) ? 1.f : 0.f; }
            S[r][2 * j] = (f32x2){z[0], z[1]}; S[r][2 * j + 1] = (f32x2){z[2], z[3]}; }
    int prow[6], pcol[6];
#pragma unroll
    for (int i = 0; i < 6; ++i) { const int p = (mem * 6 + i) * 64 + lane, row = p / 40, rem = p - row * 40, g = rem >> 3, ch = rem & 7;
        prow[i] = row > 17 ? 17 : row; pcol[i] = (g == 0 ? h * 64 : g == 1 ? 512 + h * 64 : g == 2 ? 1024 + h * 64 : g == 3 ? dwcol : 1664) + 8 * ch; }
#define SC_DMA(T0) do { _Pragma("unroll") for (int i = 0; i < 6; ++i) { int tr_ = (T0) - 1 + prow[i]; tr_ = tr_ < tok0 ? tok0 : (tr_ > tok0 + Ls - 1 ? tok0 + Ls - 1 : tr_); \
            __builtin_amdgcn_global_load_lds((const unsigned*)(A.zrw + (size_t)tr_ * RWC + pcol[i]), (LAS unsigned*)(RAW + (mem * 6 + i) * 256), 16, 0, 0); } } while (0)
    bf16x8 AF[2][4];
    { const bf16_t* wt0 = mem ? A.aupT : wupT;
#pragma unroll
      for (int ks = 0; ks < 2; ++ks)
#pragma unroll
          for (int mt = 0; mt < 4; ++mt) AF[ks][mt] = *(const bf16x8*)(wt0 + (size_t)(h * 64 + 16 * mt + (lane & 15)) * 64 + 32 * ks + 8 * (lane >> 4)); }
    const int nch = J.nst / 16;
    SC_DMA(J.seg0 + (dir ? nch - 1 : 0) * 16);
    asm volatile("s_waitcnt vmcnt(0)" ::: "memory");
    team_bar(bar, bk, lane);
    for (int ci = 0; ci < nch; ++ci) {
        const int c = dir ? nch - 1 - ci : ci; const int t0 = J.seg0 + c * 16;
        int ln = lane; asm volatile("" : "+v"(ln));
        {
            const int tk = ln & 15, hq = ln >> 4; const int t = t0 + tk; const int pos = t - tok0; const bool hp = pos > 0, hn = pos < Ls - 1;
            f32x4 acc[4];
#pragma unroll
            for (int mt = 0; mt < 4; ++mt) acc[mt] = (f32x4){0.f, 0.f, 0.f, 0.f};
#pragma unroll
            for (int ks = 0; ks < 2; ++ks) {
                const int kq = 32 * ks + 8 * hq; float x[8];
                conv8R(RAW, tk, (mem ? 32 : 24) + 4 * ks + hq, hp, hn, TB + 576 + mem * 192 + kq, x);
                if (mem == 0) {
#pragma unroll
                    for (int j = 0; j < 8; ++j) x[j] = 1.0f - 2.0f * __builtin_amdgcn_rcpf(__expf(2.0f * x[j]) + 1.0f); }
                const u32x4 pw = pack8(x); const bf16x8 bfrag = __builtin_bit_cast(bf16x8, pw);
#pragma unroll
                for (int mt = 0; mt < 4; ++mt) acc[mt] = MFMA16(AF[ks][mt], bfrag, acc[mt]);
            }
#pragma unroll
            for (int mt = 0; mt < 4; ++mt) {
                const int cc = 16 * mt + 4 * hq; const f32x4 bias = *(const LAS f32x4*)(TB + 1152 + mem * 64 + cc); f32x4 o;
#pragma unroll
                for (int j = 0; j < 4; ++j) { const float sg = sigm(bias[j] + acc[mt][j]); o[j] = mem ? sg : __expf(-0.606531f * sg); }
                *(LAS f32x4*)((mem ? LB : LW) + tk * 64 + cc) = o;
            }
        }
        team_bar(bar, bk, lane);
        {
            const int tk = 8 * mem + (ln >> 3), c0 = 8 * (ln & 7); const int t = t0 + tk; const int pos = t - tok0; const bool hp = pos > 0, hn = pos < Ls - 1;
            float rc[8], kc8[8], vc[8];
            conv8R(RAW, tk, (ln & 7), hp, hn, TB + c0, rc);
            conv8R(RAW, tk, 8 + (ln & 7), hp, hn, TB + 192 + c0, kc8);
            conv8R(RAW, tk, 16 + (ln & 7), hp, hn, TB + 384 + c0, vc);
            const int o = tk * 64 + c0;
            const f32x4 a_lo = *(const LAS f32x4*)(LB + o), a_hi = *(const LAS f32x4*)(LB + o + 4);
            const f32x4 kk_lo = *(const LAS f32x4*)(TB + 960 + c0), kk_hi = *(const LAS f32x4*)(TB + 960 + c0 + 4);
            const f32x4 ka_lo = *(const LAS f32x4*)(TB + 1024 + c0), ka_hi = *(const LAS f32x4*)(TB + 1024 + c0 + 4);
            const f32x4 rk_lo = *(const LAS f32x4*)(TB + 1088 + c0), rk_hi = *(const LAS f32x4*)(TB + 1088 + c0 + 4);
            f32x4 kr[2], kt[2], av[2]; float n2 = 0.f, bon = 0.f;
#pragma unroll
            for (int j = 0; j < 8; ++j) {
                const float a = j < 4 ? a_lo[j & 3] : a_hi[j & 3], kkw = j < 4 ? kk_lo[j & 3] : kk_hi[j & 3], kaw = j < 4 ? ka_lo[j & 3] : ka_hi[j & 3], rkw = j < 4 ? rk_lo[j & 3] : rk_hi[j & 3];
                const float kraw = kc8[j] * kkw; n2 += kraw * kraw;
                const float ktv = kc8[j] * (1.0f + (a - 1.0f) * kaw); bon += rc[j] * ktv * rkw;
                kr[j >> 2][j & 3] = kraw; kt[j >> 2][j & 3] = ktv; av[j >> 2][j & 3] = a;
            }
            n2 = red8(n2); bon = red8(bon);
            const float inv = 1.0f / fmaxf(sqrtf(n2), 1e-12f);
            *(LAS f32x4*)(LR + o) = (f32x4){rc[0], rc[1], rc[2], rc[3]}; *(LAS f32x4*)(LR + o + 4) = (f32x4){rc[4], rc[5], rc[6], rc[7]};
            if (pmode) {
#pragma unroll
                for (int j = 0; j < 8; ++j) vc[j] = 0.f; }
            *(LAS f32x4*)(LV + o) = (f32x4){vc[0], vc[1], vc[2], vc[3]}; *(LAS f32x4*)(LV + o + 4) = (f32x4){vc[4], vc[5], vc[6], vc[7]};
            *(LAS f32x4*)(LKT + o) = kt[0]; *(LAS f32x4*)(LKT + o + 4) = kt[1];
            const f32x4 k0 = kr[0] * inv, k1 = kr[1] * inv;
            *(LAS f32x4*)(LKK + o) = k0; *(LAS f32x4*)(LKK + o + 4) = k1;
            *(LAS f32x4*)(LB + o) = k0 * av[0]; *(LAS f32x4*)(LB + o + 4) = k1 * av[1];
            if (dir == 0 && (ln & 7) == 0 && !pmode) A.bonus[(size_t)t * 8 + h] = bon;
        }
        team_bar(bar, bk, lane);
        if (ci + 1 < nch) { const int cn = dir ? nch - 2 - ci : ci + 1; SC_DMA(J.seg0 + cn * 16); }
        {
            const int kc = ln & 7, rg = ln >> 3;
#define SC_LOAD(C, ST) do { const int tt_ = dir ? 15 - (ST) : (ST); const int base_ = tt_ * 64 + 8 * kc; \
                C[0] = *(const LAS f32x4*)(LKK + base_); C[1] = *(const LAS f32x4*)(LKK + base_ + 4); C[2] = *(const LAS f32x4*)(LW + base_); C[3] = *(const LAS f32x4*)(LW + base_ + 4); \
                C[4] = *(const LAS f32x4*)(LB + base_); C[5] = *(const LAS f32x4*)(LB + base_ + 4); C[6] = *(const LAS f32x4*)(LKT + base_); C[7] = *(const LAS f32x4*)(LKT + base_ + 4); \
                C[8] = *(const LAS f32x4*)(LR + base_); C[9] = *(const LAS f32x4*)(LR + base_ + 4); C[10] = *(const LAS f32x4*)(LV + tt_ * 64 + 32 * mem + 4 * rg); } while (0)
#define SC_P(C, q, i) ((f32x2){C[2 * (q) + ((i) >> 1)][2 * ((i) & 1)], C[2 * (q) + ((i) >> 1)][2 * ((i) & 1) + 1]})
#define SC_STEP(C, ST) do { const int tt_ = dir ? 15 - (ST) : (ST); float sa[4], y[4]; f32x2 q_[4]; \
                  \
                _Pragma("unroll") for (int r = 0; r < 4; ++r) q_[r] = S[r][0] * SC_P(C, 0, 0); \
                _Pragma("unroll") for (int i = 1; i < 4; ++i) { _Pragma("unroll") for (int r = 0; r < 4; ++r) q_[r] += S[r][i] * SC_P(C, 0, i); } \
                _Pragma("unroll") for (int r = 0; r < 4; ++r) sa[r] = -(q_[r].x + q_[r].y); \
                red8x4(sa[0], sa[1], sa[2], sa[3]); \
                _Pragma("unroll") for (int i = 0; i < 4; ++i) { f32x2 t_[4]; \
                    _Pragma("unroll") for (int r = 0; r < 4; ++r) t_[r] = S[r][i] * SC_P(C, 1, i); \
                    _Pragma("unroll") for (int r = 0; r < 4; ++r) t_[r] += (f32x2){sa[r], sa[r]} * SC_P(C, 2, i); \
                    _Pragma("unroll") for (int r = 0; r < 4; ++r) t_[r] += (f32x2){C[10][r], C[10][r]} * SC_P(C, 3, i); \
                    _Pragma("unroll") for (int r = 0; r < 4; ++r) { S[r][i] = t_[r]; if (i == 0) q_[r] = t_[r] * SC_P(C, 4, i); else q_[r] += t_[r] * SC_P(C, 4, i); } } \
                if (sy) { _Pragma("unroll") for (int r = 0; r < 4; ++r) y[r] = q_[r].x + q_[r].y; \
                    red8x4(y[0], y[1], y[2], y[3]); \
                    if (kc == 0) *(LAS f32x4*)(YB + tt_ * 64 + 32 * mem + 4 * rg) = (f32x4){y[0], y[1], y[2], y[3]}; } } while (0)
            const bool sy = (J.store_y != 0);
            f32x4 CA[11], CB[11];
            SC_LOAD(CA, 0);
            for (int st = 0; st < 16; st += 2) {
                SC_LOAD(CB, st + 1); asm volatile("" ::: "memory");
                SC_STEP(CA, st);
                if (st + 2 < 16) SC_LOAD(CA, st + 2);
                asm volatile("" ::: "memory");
                SC_STEP(CB, st + 1);
            }
#undef SC_LOAD
#undef SC_P
#undef SC_STEP
        }
        asm volatile("s_waitcnt vmcnt(0)" ::: "memory");
        if (J.store_y) {
            wave_lds_fence();
            const int tq = ln >> 2, pq = ln & 3; const LAS float* yp = YB + tq * 64 + 32 * mem + 8 * pq;
            *(u32x4*)(yout + (size_t)(t0 + tq) * 512 + h * 64 + 32 * mem + 8 * pq) = pack8v(*(const LAS f32x4*)yp, *(const LAS f32x4*)(yp + 4));
        }
        team_bar(bar, bk, lane);
    }
#undef SC_DMA
    if (J.carry) {
#pragma unroll
        for (int r = 0; r < 4; ++r)
#pragma unroll
            for (int j = 0; j < 2; ++j) *(f32x4*)(J.carry + (32 * mem + 4 * (lane >> 3) + r) * 64 + 8 * (lane & 7) + 4 * j) = (f32x4){S[r][2 * j].x, S[r][2 * j].y, S[r][2 * j + 1].x, S[r][2 * j + 1].y};
    }
}
DI void scan_carry_in(int c, int s, int nsc, const float* CU, const float* CP, const int mem, f32x4 (&S)[4][2], LAS float* PT, int lane) {
    const int rg = lane >> 3, kc = lane & 7;
    { const float* U0 = CU + (size_t)(c * nsc) * 4096;
#pragma unroll
      for (int r = 0; r < 4; ++r)
#pragma unroll
          for (int j = 0; j < 2; ++j) S[r][j] = *(const f32x4*)(U0 + (32 * mem + 4 * rg + r) * 64 + 8 * kc + 4 * j); }
    for (int q = 1; q < s; ++q) {
#pragma unroll
        for (int j = 0; j < 2; ++j)
#pragma unroll
            for (int e = 0; e < 4; ++e) *(LAS f32x4*)(PT + (8 * kc + 4 * j + e) * 32 + 4 * rg) = (f32x4){S[0][j][e], S[1][j][e], S[2][j][e], S[3][j][e]};
        wave_lds_fence();
        const float* Pj = CP + (size_t)(c * nsc + q) * 4096; const float* Uj = CU + (size_t)(c * nsc + q) * 4096;
#pragma unroll
        for (int r = 0; r < 4; ++r)
#pragma unroll
            for (int j = 0; j < 2; ++j) S[r][j] = *(const f32x4*)(Uj + (32 * mem + 4 * rg + r) * 64 + 8 * kc + 4 * j);
#pragma unroll 1
        for (int m0 = 0; m0 < 64; m0 += 8) {
            f32x4 pv[8][2];
#pragma unroll
            for (int u = 0; u < 8; ++u)
#pragma unroll
                for (int j = 0; j < 2; ++j) pv[u][j] = *(const f32x4*)(Pj + (m0 + u) * 64 + 8 * kc + 4 * j);
#pragma unroll
            for (int u = 0; u < 8; ++u) {
            const int m = m0 + u;
            const f32x4 sv = *(const LAS f32x4*)(PT + m * 32 + 4 * rg);
#pragma unroll
            for (int j = 0; j < 2; ++j) { const f32x4 p = pv[u][j];
#pragma unroll
                for (int r = 0; r < 4; ++r) S[r][j] += p * sv[r]; }
            }
        }
        wave_lds_fence();
    }
}

DI void post_item(int item, const bf16_t* zrw, const float* convw, const bf16_t* gupT, const bf16_t* yf, const bf16_t* ybk, const float* bonus, const float* lnw, const float* lnb, bf16_t* yb, int lane) {
    asm volatile("" : "+v"(lane));
    const int h = item & 7, tile = item >> 3, tk = lane & 31, hh = lane >> 5; const int t = tile * 32 + tk;
    const int pos = t < TP ? (t & 8191) : (t & 2047), Ls = t < TP ? 8192 : 2048; const bool hp = pos > 0, hn = pos < Ls - 1;
    f32x16 acc[2];
#pragma unroll
    for (int mt = 0; mt < 2; ++mt)
#pragma unroll
        for (int i = 0; i < 16; ++i) acc[mt][i] = 0.f;
#pragma unroll
    for (int ks = 0; ks < 8; ++ks) {
        const int col = 1728 + 16 * ks + 8 * hh; float x[8];
        conv8(zrw, (size_t)t * RWC + col, hp, hn, convw, col, x);
#pragma unroll
        for (int j = 0; j < 8; ++j) x[j] = sigm(x[j]);
        const u32x4 pw = pack8(x); const bf16x8 bfrag = __builtin_bit_cast(bf16x8, pw);
#pragma unroll
        for (int mt = 0; mt < 2; ++mt) {
            const bf16x8 afrag = *(const bf16x8*)(gupT + (size_t)(h * 64 + 32 * mt + tk) * 128 + 16 * ks + 8 * hh);
            acc[mt] = MFMA32(afrag, bfrag, acc[mt]);
        }
    }
    f32x4 y[2][4]; float sum = 0.f;
#pragma unroll
    for (int mt = 0; mt < 2; ++mt)
#pragma unroll
        for (int gi = 0; gi < 4; ++gi) {
            const size_t off = (size_t)t * 512 + h * 64 + 32 * mt + 8 * gi + 4 * hh;
            y[mt][gi] = unpack4(*(const u32x2*)(yf + off)) + unpack4(*(const u32x2*)(ybk + off));
            sum += (y[mt][gi][0] + y[mt][gi][1]) + (y[mt][gi][2] + y[mt][gi][3]);
        }
    sum += __shfl_xor(sum, 32); const float mu = sum * (1.0f / 64.0f); float qv = 0.f;
#pragma unroll
    for (int mt = 0; mt < 2; ++mt)
#pragma unroll
        for (int gi = 0; gi < 4; ++gi) { y[mt][gi] -= mu; const f32x4 s = y[mt][gi] * y[mt][gi]; qv += (s[0] + s[1]) + (s[2] + s[3]); }
    qv += __shfl_xor(qv, 32); const float rs = rsqrtf(qv * (1.0f / 64.0f) + 64e-5f);
    const float bn = bonus[(size_t)t * 8 + h];
#pragma unroll
    for (int mt = 0; mt < 2; ++mt)
#pragma unroll
        for (int gi = 0; gi < 4; ++gi) {
            const int hc = h * 64 + 32 * mt + 8 * gi + 4 * hh;
            const f32x4 v4 = conv4(zrw, (size_t)t * RWC + 1024 + hc, hp, hn, convw, 1024 + hc);
            const f32x4 lw = *(const f32x4*)(lnw + hc), lb = *(const f32x4*)(lnb + hc);
            f32x4 g4;
#pragma unroll
            for (int j = 0; j < 4; ++j) g4[j] = acc[mt][4 * gi + j];
            const f32x4 o = (y[mt][gi] * rs * lw + lb + v4 * bn) * g4;
            *(u32x2*)(yb + (size_t)t * 512 + hc) = pack4v(o);
        }
}
struct Params { const float* in[31]; float* out; unsigned char* ws; int ph_lo, ph_hi; };
constexpr int NPH = 10, NSB = 160;
__global__ void __launch_bounds__(512) mega(Params P) {
    extern __shared__ __attribute__((aligned(16))) unsigned char lds_raw[];
    PG8_LAS unsigned char* lds = (PG8_LAS unsigned char*)lds_raw;
    cg::grid_group grid = cg::this_grid();
    const int wid = __builtin_amdgcn_readfirstlane(threadIdx.x >> 6), b = blockIdx.x, G = gridDim.x;
    unsigned char* ws = P.ws;
    bf16_t *W1T = (bf16_t*)(ws + O_W1T), *W2T = (bf16_t*)(ws + O_W2T), *WpgT = (bf16_t*)(ws + O_WPGT), *WpleT = (bf16_t*)(ws + O_WPLET), *gupT = (bf16_t*)(ws + O_GUPT),
           *wupTf = (bf16_t*)(ws + O_WUPF), *wupTb = (bf16_t*)(ws + O_WUPB), *aupT = (bf16_t*)(ws + O_AUPT), *xb = (bf16_t*)(ws + O_XB), *zrw = (bf16_t*)(ws + O_ZRW),
           *ya = (bf16_t*)(ws + O_YA), *yf = (bf16_t*)(ws + O_YF), *ybk = (bf16_t*)(ws + O_YBK), *yb = (bf16_t*)(ws + O_YB), *Gb = (bf16_t*)(ws + O_G), *MG = (bf16_t*)(ws + O_MG),
           *hid = (bf16_t*)(ws + O_HID), *G7 = (bf16_t*)(ws + O_G7), *pb = (bf16_t*)(ws + O_PB), *WinT = (bf16_t*)(ws + O_WINT), *WgT = (bf16_t*)(ws + O_WGT),
           *WaT = (bf16_t*)(ws + O_WAT), *WbT = (bf16_t*)(ws + O_WBT), *WoT = (bf16_t*)(ws + O_WOT);
    float *rstd1 = (float*)(ws + O_RSTD1), *bonus = (float*)(ws + O_BONUS), *ssq2 = (float*)(ws + O_SSQ2), *ssq3 = (float*)(ws + O_SSQ3);
    unsigned* ctr = (unsigned*)(ws + O_CTR);
    bf16_t *qb = (bf16_t*)P.out, *kb = qb + (size_t)T * 512, *vT = kb + (size_t)T * 512;
    const int lo = P.ph_lo, hi = P.ph_hi;
    XcdBarrier xbar;
    { volatile LAS unsigned* st = (volatile LAS unsigned*)((LAS float*)lds + 34576); int l_; asm volatile("v_mbcnt_lo_u32_b32 %0, -1, 0\n\tv_mbcnt_hi_u32_b32 %0, -1, %0" : "=v"(l_));
      const bool ld_ = (wid == 0 && l_ == 0); if (ld_) { st[0] = 0u; st[1] = 0u; }
      __syncthreads();
      xbar.bar = (unsigned*)(ws + O_BAR); xbar.x = xb_xcc_id(); xbar.st = st; if (ld_) (void)xb_add(&xbar.bar[XB_XCNT(xbar.x)], 1u); }
#define IN(k) (lo <= (k) && (k) < hi)
#define GET_TID() int lane; asm volatile("v_mbcnt_lo_u32_b32 %0, -1, 0\n\tv_mbcnt_hi_u32_b32 %0, -1, %0" : "=v"(lane)); const int tid = wid * 64 + lane; (void)tid
#define GBAR() do { int l_; asm volatile("v_mbcnt_lo_u32_b32 %0, -1, 0\n\tv_mbcnt_hi_u32_b32 %0, -1, %0" : "=v"(l_)); xcd_barrier(xbar, wid == 0 && l_ == 0); } while (0)
#define SEAM(k) do { if (IN(k) && IN((k) + 1)) { if ((k) == 0) grid.sync(); else GBAR(); } } while (0)

    if (IN(0)) {
        GET_TID();
        LAS float* tl = (LAS float*)lds;
        p0_transpose(tl, P.in[5], 5440, 1024, 3584, WinT, P.in[4], 1, 0, G, b, tid);
        p0_transpose(tl, P.in[5], 5440, 1024, 2048, WgT, P.in[4], 0, 3392, G, b, tid);
        p0_transpose(tl, P.in[22], 1024, 512, 1024, WaT, nullptr, 0, 0, G, b, tid);
        p0_transpose(tl, P.in[23], 1024, 512, 1024, WbT, nullptr, 0, 0, G, b, tid);
        p0_transpose(tl, P.in[24], 1024, 1024, 1024, WoT, nullptr, 0, 0, G, b, tid);
        p0_transpose(tl, P.in[26], 4096, 1024, 4096, W1T, P.in[25], 0, 0, G, b, tid);
        p0_transpose(tl, P.in[27], 1024, 4096, 1024, W2T, nullptr, 0, 0, G, b, tid);
        p0_transpose(tl, P.in[30], 1024, 1024, 1024, WpgT, P.in[29], 0, 0, G, b, tid);
        p0_transpose(tl, P.in[28], 1024, 256, 1024, WpleT, nullptr, 0, 0, G, b, tid);
        p0_transpose(tl, P.in[16], 512, 128, 512, gupT, nullptr, 0, 0, G, b, tid);
        p0_transpose(tl, P.in[11], 512, 64, 512, wupTf, nullptr, 0, 0, G, b, tid);
        p0_transpose(tl, P.in[13], 512, 64, 512, wupTb, nullptr, 0, 0, G, b, tid);
        p0_transpose(tl, P.in[15], 512, 64, 512, aupT, nullptr, 0, 0, G, b, tid);
        for (int row0 = b * 8 + wid; row0 < T; row0 += 2 * G * 8) {
            f32x4 v[2][4]; float ss[2];
#pragma unroll
            for (int u = 0; u < 2; ++u) { const int row = row0 + u * G * 8; const float* xr = row < TP ? P.in[0] + (size_t)row * 1024 : P.in[1] + (size_t)(row - TP) * 1024;
#pragma unroll
                for (int j = 0; j < 4; ++j) v[u][j] = *(const f32x4*)(xr + j * 256 + lane * 4); }
#pragma unroll
            for (int u = 0; u < 2; ++u) { const int row = row0 + u * G * 8; ss[u] = 0.f;
#pragma unroll
                for (int j = 0; j < 4; ++j) { const f32x4 s = v[u][j] * v[u][j]; ss[u] += (s[0] + s[1]) + (s[2] + s[3]); }
#pragma unroll
                for (int o = 32; o >= 1; o >>= 1) ss[u] += __shfl_xor(ss[u], o);
#pragma unroll
                for (int j = 0; j < 4; ++j) *(u32x2*)(xb + (size_t)row * 1024 + j * 256 + lane * 4) = pack4v(v[u][j]);
                if (lane == 0) rstd1[row] = rsqrtf(ss[u] * (1.0f / 1024.0f) + 1e-6f); }
        }
        if (b == 0 && tid < 8) ctr[64 * tid] = 0u;
    }
    SEAM(0);
    if (IN(1)) {
        GET_TID();
        Gemm g{xb, WinT, T, 3584, 1024}; StaticOrder S; S.init(T, 3584, G, b);
        EpiG1 E{qb, kb, vT, zrw, rstd1, P.in[7], P.in[8]};
        gemm_phase<EpiG1, StaticOrder>(lds, g, S, E, nullptr, tid);
    }
    SEAM(1);
    if (IN(2)) {
        GET_TID();
        ScanArgs SA{zrw, P.in[6], wupTf, wupTb, aupT, P.in[10], P.in[12], P.in[14], P.in[17], P.in[18], P.in[19], bonus, yf, ybk};
        float *CU = (float*)(ws + O_YB), *CP = CU + (size_t)256 * 4096, *CS = CP + (size_t)256 * 4096;
        const int sl = wid % 3, mem = wid / 3;
        LAS float* Lw = (LAS float*)lds + sl * 11520; LAS float* RAWw = Lw + 6144; LAS float* TBw = Lw + 10240;
        f32x4 SI[4][2];
#pragma unroll
        for (int r = 0; r < 4; ++r) { SI[r][0] = (f32x4){0.f, 0.f, 0.f, 0.f}; SI[r][1] = (f32x4){0.f, 0.f, 0.f, 0.f}; }
        LAS unsigned* bars = (LAS unsigned*)((LAS float*)lds + 34560); unsigned bk = 0u;
        if (tid < 3) bars[tid] = 0u;
        __syncthreads();
        {
            const int slot = sl * G + b;
            if (wid < 6 && slot < 672) {
                ScanJob J; J.nst = 1024;
                if (slot < 416) { int c, s, pm; if (slot < 224) { c = slot / 7; s = slot % 7; pm = 0; } else { const int j = slot - 224; c = j / 6; s = 1 + j % 6; pm = 1; }
                    J.tok0 = (c >> 4) * 8192; J.Ls = 8192; J.h = (c >> 1) & 7; J.dir = c & 1; J.seg0 = J.tok0 + (J.dir ? 7 - s : s) * 1024;
                    J.init = pm; J.store_y = (!pm && s == 0) ? 1 : 0; J.carry = (pm ? CP : CU) + (size_t)(c * 8 + s) * 4096; }
                else { const int c = slot - 416; J.tok0 = TP + (c >> 4) * 2048; J.Ls = 2048; J.h = (c >> 1) & 7; J.dir = c & 1; J.seg0 = J.tok0 + (J.dir ? 1 : 0) * 1024; J.init = 0; J.store_y = 1; J.carry = CS + (size_t)c * 4096; }
                scan_team(J, mem, Lw, RAWw, TBw, bars + sl, bk, SI, SA, lane);
            }
            {
                const unsigned xq = xb_xcc_id() & 7u;
                for (unsigned kq = 0; kq < 8u; ++kq) {
                    const unsigned qx = (xq + kq) & 7u;
                    for (;;) {
                        unsigned idx = 0; if (lane == 0) idx = atomicAdd(ctr + 64 * qx, 1u);
                        idx = __builtin_amdgcn_readfirstlane(idx);
                        if (idx >= 3072u) break;
                        na_item((int)(qx * 3072u + idx), qb, kb, vT, P.in[9], ya, lane);
                    }
                }
            }
        }
        GBAR();
        if (tid < 3) bars[tid] = 0u;
        bk = 0u;
        __syncthreads();
        if (b < NSB) {
            const int slot = sl * NSB + b;
            if (wid < 6 && slot < 480) {
                ScanJob J; J.nst = 1024; J.init = 2; J.store_y = 1; J.carry = nullptr;
                LAS float* PTw = Lw + (mem & 1) * 2048;
                if (slot < 224) { const int c = slot / 7, s = 1 + slot % 7; J.tok0 = (c >> 4) * 8192; J.Ls = 8192; J.h = (c >> 1) & 7; J.dir = c & 1; J.seg0 = J.tok0 + (J.dir ? 7 - s : s) * 1024;
                    scan_carry_in(c, s, 8, CU, CP, mem, SI, PTw, lane); }
                else { const int c = slot - 224; J.tok0 = TP + (c >> 4) * 2048; J.Ls = 2048; J.h = (c >> 1) & 7; J.dir = c & 1; J.seg0 = J.tok0 + (J.dir ? 0 : 1) * 1024;
                    scan_carry_in(c, 1, 1, CS, CS, mem, SI, PTw, lane); }
                team_bar(bars + sl, bk, lane);
                scan_team(J, mem, Lw, RAWw, TBw, bars + sl, bk, SI, SA, lane);
            }
        } else {
            Gemm g{xb, WgT, T, 2048, 1024}; StaticOrder S; S.init(T, 2048, G - NSB, b - NSB);
            EpiB<0> E{(bf16_t*)P.out, 2048, rstd1, nullptr, 0};
            gemm_phase<EpiB<0>, StaticOrder>(lds, g, S, E, nullptr, tid);
        }
    }
    SEAM(2);
    if (IN(3)) {
        GET_TID();
        for (int item = b * 8 + wid; item < 12288; item += G * 8) post_item(item, zrw, P.in[6], gupT, yf, ybk, bonus, P.in[20], P.in[21], yb, lane);
    }
    SEAM(3);
    if (IN(4)) {
        GET_TID();
        StaticOrder S; S.init(T, 1024, G, b);
        const bf16_t* G2 = (const bf16_t*)P.out;
        { Gemm g{ya, WaT, T, 1024, 512}; EpiB<1> E{MG, 1024, nullptr, G2, 2048}; gemm_phase<EpiB<1>, StaticOrder>(lds, g, S, E, nullptr, tid); }
        { Gemm g{yb, WbT, T, 1024, 512}; EpiB<2> E{MG, 1024, nullptr, G2 + 1024, 2048}; gemm_phase<EpiB<2>, StaticOrder>(lds, g, S, E, nullptr, tid); }
    }
    SEAM(4);
    if (IN(5)) {
        GET_TID();
        Gemm g{MG, WoT, T, 1024, 1024}; StaticOrder S; S.init(T, 1024, G, b);
        EpiF<0> E{nullptr, nullptr, nullptr, xb, ssq2, nullptr, nullptr};
        gemm_phase<EpiF<0>, StaticOrder>(lds, g, S, E, nullptr, tid);
    }
    SEAM(5);
    if (IN(6)) {
        GET_TID();
        Gemm g{xb, W1T, T, 4096, 1024}; StaticOrder S; S.init(T, 4096, G, b);
        EpiB<3> E{hid, 4096, ssq2, nullptr, 0};
        gemm_phase<EpiB<3>, StaticOrder>(lds, g, S, E, nullptr, tid);
    }
    SEAM(6);
    if (IN(7)) {
        GET_TID();
        Gemm g{hid, W2T, T, 1024, 4096}; StaticOrder S; S.init(T, 1024, G, b);
        EpiF<0> E{nullptr, nullptr, P.out, xb, ssq3, nullptr, nullptr};
        gemm_phase<EpiF<0>, StaticOrder>(lds, g, S, E, nullptr, tid);
    }
    SEAM(7);
    if (IN(8)) {
        GET_TID();
        Gemm g{xb, WpgT, T, 1024, 1024}; StaticOrder S; S.init(T, 1024, G, b);
        EpiF<1> E{nullptr, nullptr, nullptr, G7, nullptr, ssq3, nullptr};
        gemm_phase<EpiF<1>, StaticOrder>(lds, g, S, E, nullptr, tid);
        for (int i = b * 512 + tid; i < T * 32; i += G * 512) {
            const int row = i >> 5, c8 = (i & 31) * 8;
            const float* src = row < TP ? P.in[2] + (size_t)row * 256 + c8 : P.in[3] + (size_t)(row - TP) * 256 + c8;
            *(u32x4*)(pb + (size_t)row * 256 + c8) = pack8v(*(const f32x4*)src, *(const f32x4*)(src + 4));
        }
    }
    SEAM(8);
    if (IN(9)) {
        GET_TID();
        Gemm g{pb, WpleT, T, 1024, 256}; StaticOrder S; S.init(T, 1024, G, b);
        EpiF<2> E{nullptr, nullptr, P.out, G7, nullptr, nullptr, xb};
        gemm_phase<EpiF<2>, StaticOrder>(lds, g, S, E, nullptr, tid);
    }
#undef IN
#undef SEAM
}

extern "C" void kernel_launch(void* const* d_in, const int* in_sizes, int n_in, void* d_out, int out_size, void* d_ws, size_t ws_size, hipStream_t stream) {
    static int grid_blocks = 0;
    if (grid_blocks == 0) {
        if (n_in != 31 || out_size != T * 1024 || ws_size < WS_NEED) { fprintf(stderr, "kernel_launch: unexpected shapes (n_in %d out %d ws %zu)\n", n_in, out_size, ws_size); grid_blocks = -1; return; }
        int dev = 0, cus = 0, per_cu = 0;
        hipGetDevice(&dev); hipDeviceGetAttribute(&cus, hipDeviceAttributeMultiprocessorCount, dev);
        if (hipFuncSetAttribute((const void*)mega, hipFuncAttributeMaxDynamicSharedMemorySize, LDS_BYTES) != hipSuccess) { fprintf(stderr, "kernel_launch: hipFuncSetAttribute failed\n"); grid_blocks = -1; return; }
        hipOccupancyMaxActiveBlocksPerMultiprocessor(&per_cu, (const void*)mega, 512, LDS_BYTES);
        if (per_cu < 1) { fprintf(stderr, "kernel_launch: occupancy query says %d blocks per CU\n", per_cu); grid_blocks = -1; return; }
        grid_blocks = cus;
    }
    if (grid_blocks < 0) return;
    Params p{};
    for (int i = 0; i < 31; ++i) p.in[i] = (const float*)d_in[i];
    p.out = (float*)d_out; p.ws = (unsigned char*)d_ws;
    if (hipMemsetAsync((unsigned char*)d_ws + O_BAR, 0, XCD_BAR_WORDS * 4, stream) != hipSuccess) { fprintf(stderr, "kernel_launch: memset of the barrier words failed\n"); return; }
#if defined(SPLIT_LAUNCH)
    for (int ph = 0; ph < NPH; ++ph) { p.ph_lo = ph; p.ph_hi = ph + 1; hipLaunchKernelGGL(mega, dim3(grid_blocks), dim3(512), LDS_BYTES, stream, p); }
#else
    p.ph_lo = 0; p.ph_hi = NPH;
    void* args[] = {&p};
    hipError_t e = hipLaunchCooperativeKernel((const void*)mega, dim3(grid_blocks), dim3(512), args, LDS_BYTES, stream);
    if (e != hipSuccess) fprintf(stderr, "cooperative launch failed: %s (grid %d)\n", hipGetErrorString(e), grid_blocks);
#endif
}
```

```cpp
#include <hip/hip_runtime.h>
#include <hip/hip_cooperative_groups.h>
#include <cstdio>
namespace pg8 {
#define PG8_LAS __attribute__((address_space(3)))
typedef unsigned short bf16_t;
typedef short bf16x8 __attribute__((ext_vector_type(8)));
typedef float f32x4 __attribute__((ext_vector_type(4)));
typedef unsigned u32x4 __attribute__((ext_vector_type(4)));
constexpr int BM = 256, BK = 64, HALF = 128, HTB = HALF * BK * 2  , STAGE_BYTES = 8 * HTB, NXCD = 8, WGM = 8;

__host__ __device__ __forceinline__ int lds_byte(int r, int c) { const int st = (r >> 4) * 2 + (c >> 5), rr = r & 15, cc = c & 31, ob = rr * 64 + cc * 2; return st * 1024 + (ob ^ (((ob >> 9) & 1) << 5)); }
__host__ __device__ __forceinline__ void stage_rc(int b, int& R, int& C) { const int st = b / 1024, sb = b % 1024, swz = sb ^ (((sb >> 9) & 1) << 5); R = (st >> 1) * 16 + swz / 64; C = (st & 1) * 32 + (swz % 64) / 2; }
__host__ __device__ __forceinline__ int perm32(int rho) { const int n = rho >> 4, i = rho & 15; return 8 * (i >> 2) + 4 * n + (i & 3); }

struct Unit { int pm, pn; };
struct Gemm { const bf16_t* A; const bf16_t* Bt; int M, N, K; };

struct StaticOrder {
    int nM, nN, nwg, G, c;
    __host__ __device__ void init(int M, int N, int G_, int c_) { nM = M / BM; nN = N / BM; nwg = nM * nN; G = G_; c = c_; }
    __host__ __device__ bool next(int i, Unit& u) const {
        const long L = (long)i * G + c; if (L >= nwg) return false;
        int wgid = (int)L; { const int q = nwg / NXCD, r = nwg % NXCD, xcd = wgid % NXCD, off = wgid / NXCD; wgid = (xcd < r ? xcd * (q + 1) : r * (q + 1) + (xcd - r) * q) + off; }
        const int nig = WGM * nN, gid = wgid / nig, fm = gid * WGM, gsz = (nM - fm) < WGM ? (nM - fm) : WGM;
        u.pm = fm + ((wgid % nig) % gsz); u.pn = (wgid % nig) / gsz; return true;
    }
    __device__ __forceinline__ void a_ready(const Unit&) const {}
    __device__ __forceinline__ void done(const Unit&) const {}
};
typedef __bf16 bf16x2v_t __attribute__((ext_vector_type(2)));
typedef float f32x2 __attribute__((ext_vector_type(2)));
__device__ __forceinline__ unsigned cvt_pk_bf16(float lo, float hi) { const f32x2 v = (f32x2){lo, hi}; const bf16x2v_t b = __builtin_convertvector(v, bf16x2v_t); return __builtin_bit_cast(unsigned, b); }
template <class Epi, class Sched, bool STAMP = false>
__device__ __forceinline__ void gemm_phase(PG8_LAS unsigned char* lds, const Gemm g, const Sched& S, const Epi& E, unsigned long long* stamps, const int tid) {
    const int wid = __builtin_amdgcn_readfirstlane(tid >> 6), lane = tid & 63, wr = wid >> 2, wc = wid & 3, fr = lane & 15, fq = lane >> 4;
    const int K = g.K, nt = K / BK;
    int ts_lo = 0, ts_hi = 0, nts = 0; const unsigned long long rt_entry = STAMP ? (unsigned long long)wall_clock64() : 0ull;
#define PG8_STAMP() do { if (STAMP && wid == 0 && nts < 64) { const unsigned long long _c = (unsigned long long)clock64(); \
        ts_lo = (lane == nts) ? (int)(unsigned)_c : ts_lo; ts_hi = (lane == nts) ? (int)(unsigned)(_c >> 32) : ts_hi; ++nts; } } while (0)
    PG8_STAMP();
    unsigned voffA[2], voffB[2];
#pragma unroll
    for (int i = 0; i < 2; ++i) { int R, C; stage_rc(tid * 16 + i * 8192, R, C); const int Rb = Epi::PERM ? ((R & ~31) + perm32(R & 31)) : R;
        voffA[i] = (unsigned)(R * K + C) * 2u; voffB[i] = (unsigned)(Rb * K + C) * 2u; }
    const size_t kstep = (size_t)(BK * 2);
    const size_t hstep = (size_t)HALF * K * 2;
    const size_t tstep = 2 * hstep;
    const unsigned ldsw = (unsigned)wid * 1024u;
    const int aoff = lds_byte(wr * 64 + fr, fq * 8), boff = lds_byte(wc * 32 + fr, fq * 8);
#define PG8_SA(b, h) (((b) * 2 + (h)) * HTB)
#define PG8_SB(b, h) ((4 + (b) * 2 + (h)) * HTB)
#define PG8_STAGE(bufoff, gbase, voff) do { _Pragma("unroll") for (int _i = 0; _i < 2; ++_i) \
        __builtin_amdgcn_global_load_lds((const unsigned*)((const char*)(gbase) + (voff)[_i]), (PG8_LAS unsigned*)(lds + (bufoff) + ldsw + _i * 8192), 16, 0, 0); } while (0)
#define PG8_LDA(dst, b, h) do { _Pragma("unroll") for (int m = 0; m < 4; ++m) _Pragma("unroll") for (int k = 0; k < 2; ++k) dst[m][k] = *(const PG8_LAS bf16x8*)(lds + PG8_SA(b, h) + aoff + m * 2048 + k * 1024); } while (0)
#define PG8_LDB(dst, b, h) do { _Pragma("unroll") for (int n = 0; n < 2; ++n) _Pragma("unroll") for (int k = 0; k < 2; ++k) dst[n][k] = *(const PG8_LAS bf16x8*)(lds + PG8_SB(b, h) + boff + n * 2048 + k * 1024); } while (0)
#define PG8_MMA(ai, bj, At, Bt) do { __builtin_amdgcn_s_setprio(1); _Pragma("unroll") for (int m = 0; m < 4; ++m) _Pragma("unroll") for (int n = 0; n < 2; ++n) _Pragma("unroll") for (int k = 0; k < 2; ++k) \
        acc[ai][bj][m][n] = __builtin_amdgcn_mfma_f32_16x16x32_bf16(Bt[n][k], At[m][k], acc[ai][bj][m][n], 0, 0, 0); __builtin_amdgcn_s_setprio(0); } while (0)
#define PG8_WAIT_V(n) asm volatile("s_waitcnt vmcnt(" #n ")" ::: "memory")
#define PG8_WAIT_L(n) asm volatile("s_waitcnt lgkmcnt(" #n ")" ::: "memory")
#define PG8_BAR __builtin_amdgcn_s_barrier()
#define PG8_SCHED __builtin_amdgcn_sched_barrier(0)
    Unit cur, nxt; int ui = 0;
    if (!S.next(0, cur)) return;
    f32x4 acc[2][2][4][2];
#pragma unroll
    for (int a = 0; a < 2; ++a)
#pragma unroll
        for (int b = 0; b < 2; ++b)
#pragma unroll
            for (int m = 0; m < 4; ++m)
#pragma unroll
                for (int n = 0; n < 2; ++n) acc[a][b][m][n] = (f32x4){0.f, 0.f, 0.f, 0.f};
    bf16x8 At[4][2], B0[2][2], B1[2][2];
    const char* cA = (const char*)g.A + (size_t)cur.pm * tstep; const char* cB = (const char*)g.Bt + (size_t)cur.pn * tstep;
    S.a_ready(cur);
    PG8_STAGE(PG8_SB(0, 0), cB, voffB); PG8_STAGE(PG8_SA(0, 0), cA, voffA); PG8_STAGE(PG8_SB(0, 1), cB + hstep, voffB); PG8_STAGE(PG8_SA(0, 1), cA + hstep, voffA);
    if (wr == 1) PG8_BAR;
    PG8_WAIT_V(4); PG8_BAR;
    PG8_STAGE(PG8_SB(1, 0), cB + kstep, voffB); PG8_STAGE(PG8_SA(1, 0), cA + kstep, voffA); PG8_STAGE(PG8_SB(1, 1), cB + hstep + kstep, voffB);
    PG8_WAIT_V(6); PG8_BAR;
    PG8_STAMP();
    for (;;) {
        const bool has_next = S.next(ui + 1, nxt);
        const char* nA = has_next ? (const char*)g.A + (size_t)nxt.pm * tstep : cA; const char* nB = has_next ? (const char*)g.Bt + (size_t)nxt.pn * tstep : cB;
        for (int t = 0; t < nt; t += 2) {
            const bool last = (t == nt - 2);
            const char* a1 = cA + (size_t)(t + 1) * kstep;
            const char* a2 = last ? nA : cA + (size_t)(t + 2) * kstep; const char* b2 = last ? nB : cB + (size_t)(t + 2) * kstep;
            const char* a3 = a2 + kstep; const char* b3 = b2 + kstep;
            if (last && has_next) S.a_ready(nxt);
            PG8_LDB(B0, 0, 0); PG8_SCHED; PG8_LDA(At, 0, 0); PG8_STAGE(PG8_SA(1, 1), a1 + hstep, voffA);
            PG8_WAIT_L(8); PG8_BAR; PG8_WAIT_L(0); PG8_MMA(0, 0, At, B0); PG8_BAR; PG8_SCHED;
            PG8_LDB(B1, 0, 1); PG8_STAGE(PG8_SB(0, 0), b2, voffB);
            PG8_BAR; PG8_WAIT_L(0); PG8_MMA(0, 1, At, B1); PG8_BAR;
            PG8_LDA(At, 0, 1); PG8_STAGE(PG8_SA(0, 0), a2, voffA);
            PG8_BAR; PG8_WAIT_L(0); PG8_MMA(1, 0, At, B0); PG8_BAR; PG8_SCHED;
            PG8_STAGE(PG8_SB(0, 1), b2 + hstep, voffB);
            PG8_WAIT_V(6); PG8_BAR; PG8_MMA(1, 1, At, B1); PG8_BAR;
            PG8_LDB(B0, 1, 0); PG8_SCHED; PG8_LDA(At, 1, 0); PG8_STAGE(PG8_SA(0, 1), a2 + hstep, voffA);
            PG8_WAIT_L(8); PG8_BAR; PG8_WAIT_L(0); PG8_MMA(0, 0, At, B0); PG8_BAR; PG8_SCHED;
            PG8_LDB(B1, 1, 1); PG8_STAGE(PG8_SB(1, 0), b3, voffB);
            PG8_BAR; PG8_WAIT_L(0); PG8_MMA(0, 1, At, B1); PG8_BAR;
            PG8_LDA(At, 1, 1); PG8_STAGE(PG8_SA(1, 0), a3, voffA);
            PG8_BAR; PG8_WAIT_L(0); PG8_MMA(1, 0, At, B0); PG8_BAR; PG8_SCHED;
            PG8_STAGE(PG8_SB(1, 1), b3 + hstep, voffB);
            PG8_WAIT_V(6); PG8_BAR; PG8_MMA(1, 1, At, B1); PG8_BAR;
        }
        PG8_STAMP();
        if constexpr (!Epi::AFTER_DRAIN) { E(acc, cur, wr, wc, fr, fq); S.done(cur); }
        PG8_STAMP();
        if (!has_next) break;
#pragma unroll
        for (int a = 0; a < 2; ++a)
#pragma unroll
            for (int b = 0; b < 2; ++b)
#pragma unroll
                for (int m = 0; m < 4; ++m)
#pragma unroll
                    for (int n = 0; n < 2; ++n) acc[a][b][m][n] = (f32x4){0.f, 0.f, 0.f, 0.f};
        cur = nxt; cA = nA; cB = nB; ++ui;
    }
    PG8_WAIT_V(0);
    if (wr == 0) PG8_BAR;
    PG8_BAR;
    if constexpr (Epi::AFTER_DRAIN) { E.fused(acc, cur, wr, wc, fr, fq, lds, wid, lane); S.done(cur); }
    PG8_STAMP();
    if (STAMP && wid == 0) { stamps[lane] = lane < nts ? (((unsigned long long)(unsigned)ts_hi << 32) | (unsigned)ts_lo) : 0ull;
        if (lane == 62) stamps[62] = rt_entry; if (lane == 63) stamps[63] = (unsigned long long)wall_clock64(); }
#undef PG8_STAMP
#undef PG8_SA
#undef PG8_SB
#undef PG8_STAGE
#undef PG8_LDA
#undef PG8_LDB
#undef PG8_MMA
#undef PG8_WAIT_V
#undef PG8_WAIT_L
#undef PG8_BAR
#undef PG8_SCHED
}
}
using namespace pg8;
namespace cg = cooperative_groups;
typedef float f32x16 __attribute__((ext_vector_type(16)));
typedef unsigned u32x2 __attribute__((ext_vector_type(2)));
#define LAS __attribute__((address_space(3)))
#define DI __device__ __forceinline__

constexpr int T = 49152, TP = 16384, RWC = 1856;
constexpr size_t MiB = (size_t)1 << 20;
constexpr size_t O_W1T = 0, O_W2T = 8 * MiB, O_WPGT = 16 * MiB, O_WPLET = 18 * MiB, O_GUPT = 18 * MiB + 512 * 1024, O_WUPF = O_GUPT + 128 * 1024,
    O_WUPB = O_WUPF + 64 * 1024, O_AUPT = O_WUPB + 64 * 1024, O_RSTD1 = 19 * MiB, O_BONUS = 19 * MiB + 256 * 1024, O_SSQ2 = 21 * MiB, O_SSQ3 = 24 * MiB,
    O_CTR = 27 * MiB, O_BAR = 27 * MiB + 4096, O_CARU = 28 * MiB, O_CARP = 30 * MiB, O_XB = 32 * MiB, O_ZRW = 128 * MiB, O_YA = 302 * MiB, O_YF = 350 * MiB, O_YBK = 398 * MiB, O_YB = 446 * MiB, O_G = 128 * MiB,
    O_MG = 350 * MiB, O_HID = 128 * MiB, O_G7 = 128 * MiB, O_PB = 224 * MiB, O_WINT = 496 * MiB, O_WGT = 503 * MiB, O_WAT = 507 * MiB, O_WBT = 508 * MiB,
    O_WOT = 509 * MiB, WS_NEED = 512 * MiB;
constexpr int LDS_BYTES = 3 * 11520 * 4 + 128;

DI float bflo(unsigned u) { return __uint_as_float(u << 16); }
DI float bfhi(unsigned u) { return __uint_as_float(u & 0xffff0000u); }
DI float sigm(float x) { return __builtin_amdgcn_rcpf(1.0f + __expf(-x)); }
DI u32x4 pack8(const float* f) { u32x4 w; w.x = cvt_pk_bf16(f[0], f[1]); w.y = cvt_pk_bf16(f[2], f[3]); w.z = cvt_pk_bf16(f[4], f[5]); w.w = cvt_pk_bf16(f[6], f[7]); return w; }
DI u32x4 pack8v(f32x4 a, f32x4 b) { u32x4 w; w.x = cvt_pk_bf16(a[0], a[1]); w.y = cvt_pk_bf16(a[2], a[3]); w.z = cvt_pk_bf16(b[0], b[1]); w.w = cvt_pk_bf16(b[2], b[3]); return w; }
DI u32x2 pack4v(f32x4 a) { u32x2 w; w.x = cvt_pk_bf16(a[0], a[1]); w.y = cvt_pk_bf16(a[2], a[3]); return w; }
DI void unpack8(u32x4 w, f32x4& a, f32x4& b) { a = (f32x4){bflo(w.x), bfhi(w.x), bflo(w.y), bfhi(w.y)}; b = (f32x4){bflo(w.z), bfhi(w.z), bflo(w.w), bfhi(w.w)}; }
DI f32x4 unpack4(u32x2 w) { return (f32x4){bflo(w.x), bfhi(w.x), bflo(w.y), bfhi(w.y)}; }
DI float dpp_xor1(float x) { return __int_as_float(__builtin_amdgcn_mov_dpp(__float_as_int(x), 0xB1, 0xF, 0xF, true)); }
DI float dpp_xor2(float x) { return __int_as_float(__builtin_amdgcn_mov_dpp(__float_as_int(x), 0x4E, 0xF, 0xF, true)); }
DI void wave_lds_fence() { asm volatile("s_waitcnt lgkmcnt(0)" ::: "memory"); __builtin_amdgcn_wave_barrier(); }
#define MFMA32(a, b, c) __builtin_amdgcn_mfma_f32_32x32x16_bf16((a), (b), (c), 0, 0, 0)
#define MFMA16(a, b, c) __builtin_amdgcn_mfma_f32_16x16x32_bf16((a), (b), (c), 0, 0, 0)


#define XB_TMO      128
#define XB_XCNT(j)  (256  + 64 * (j))
#define XB_XSUB(j)  (1280 + 64 * (j))
#define XB_XGEN(j)  (2304 + 64 * (j))
#define XB_TOP      3328
#define XB_TOPGEN   3392
#define XCD_BAR_WORDS 3456
#define XB_SPIN_CAP (1u << 20)
DI unsigned xb_ld(unsigned* p)              { return __hip_atomic_load(p, __ATOMIC_RELAXED, __HIP_MEMORY_SCOPE_AGENT); }
DI unsigned xb_add(unsigned* p, unsigned v) { return __hip_atomic_fetch_add(p, v, __ATOMIC_RELAXED, __HIP_MEMORY_SCOPE_AGENT); }
DI unsigned xb_xcc_id() { return (unsigned)__builtin_amdgcn_s_getreg((3 << 11) | 20) & 0xFu; }
#define XB_SPIN(cond, bar) do { unsigned _sp = 0; while (cond) { __builtin_amdgcn_s_sleep(1); \
    if ((++_sp & 255u) == 0u) { if (xb_ld(&(bar)[XB_TMO])) break; if (_sp > XB_SPIN_CAP) { atomicAdd(&(bar)[XB_TMO], 1u); break; } } } } while (0)
struct XcdBarrier { unsigned* bar; unsigned x; volatile LAS unsigned* st; };
DI void xcd_barrier_complete(unsigned* bar, unsigned x, unsigned& nloc, unsigned& nx) {
    const unsigned G = gridDim.x;
    unsigned sum, cnt, mine, sp = 0u;
    for (;;) {
        sum = 0u; cnt = 0u; mine = 0u;
#pragma unroll
        for (unsigned j = 0; j < 16; ++j) { const unsigned c = xb_ld(&bar[XB_XCNT(j)]); sum += c; cnt += (c > 0u) ? 1u : 0u; mine = (j == x) ? c : mine; }
        if (sum == G) break;
        __builtin_amdgcn_s_sleep(1);
        if ((++sp & 255u) == 0u) { if (xb_ld(&bar[XB_TMO])) break; if (sp > XB_SPIN_CAP) { atomicAdd(&bar[XB_TMO], 1u); break; } }
    }
    nloc = mine > 0u ? mine : 1u; nx = cnt > 0u ? cnt : 1u;
}
DI void xcd_barrier(const XcdBarrier& b, const bool leader) {
    asm volatile("s_waitcnt vmcnt(0)" ::: "memory");
    __syncthreads();
    if (leader) {
        unsigned* bar = b.bar;
        __builtin_amdgcn_s_waitcnt(0);
        unsigned nloc = b.st[0], nx = b.st[1];
        if (nloc == 0u) { xcd_barrier_complete(bar, b.x, nloc, nx); b.st[0] = nloc; b.st[1] = nx; }
        const unsigned old = xb_add(&bar[XB_XSUB(b.x)], 1u);
        const unsigned gen = old / nloc;
        if (old + 1u == (gen + 1u) * nloc) {
            __builtin_amdgcn_fence(__ATOMIC_RELEASE, "agent");
            asm volatile("s_waitcnt vmcnt(0)" ::: "memory");
            const unsigned og = xb_add(&bar[XB_TOP], 1u);
            const unsigned tg = og / nx;
            if (og + 1u == (tg + 1u) * nx) xb_add(&bar[XB_TOPGEN], 1u);
            else XB_SPIN(xb_ld(&bar[XB_TOPGEN]) == tg, bar);
            __builtin_amdgcn_fence(__ATOMIC_ACQUIRE, "agent");
            xb_add(&bar[XB_XGEN(b.x)], 1u);
            asm volatile("s_waitcnt vmcnt(0)" ::: "memory");
        } else {
            XB_SPIN(xb_ld(&bar[XB_XGEN(b.x)]) == gen, bar);
            __builtin_amdgcn_fence(__ATOMIC_ACQUIRE, "agent");
            asm volatile("s_waitcnt vmcnt(0)" ::: "memory");
        }
    }
    __syncthreads();
}
DI void conv8(const bf16_t* z, size_t rowoff, bool hp, bool hn, const float* cw, int col, float* out) {
    const u32x4 zz = (u32x4){0u, 0u, 0u, 0u};
    const u32x4 a = hp ? *(const u32x4*)(z + rowoff - RWC) : zz;
    const u32x4 b = *(const u32x4*)(z + rowoff);
    const u32x4 c = hn ? *(const u32x4*)(z + rowoff + RWC) : zz;
    const f32x4 w0a = *(const f32x4*)(cw + col), w0b = *(const f32x4*)(cw + col + 4);
    const f32x4 w1a = *(const f32x4*)(cw + RWC + col), w1b = *(const f32x4*)(cw + RWC + col + 4);
    const f32x4 w2a = *(const f32x4*)(cw + 2 * RWC + col), w2b = *(const f32x4*)(cw + 2 * RWC + col + 4);
    f32x4 a0, a1, b0, b1, c0, c1; unpack8(a, a0, a1); unpack8(b, b0, b1); unpack8(c, c0, c1);
    const f32x4 o0 = a0 * w0a + b0 * w1a + c0 * w2a, o1 = a1 * w0b + b1 * w1b + c1 * w2b;
#pragma unroll
    for (int j = 0; j < 4; ++j) { out[j] = o0[j]; out[4 + j] = o1[j]; }
}
DI f32x4 conv4(const bf16_t* z, size_t rowoff, bool hp, bool hn, const float* cw, int col) {
    const u32x2 zz = (u32x2){0u, 0u};
    const u32x2 a = hp ? *(const u32x2*)(z + rowoff - RWC) : zz;
    const u32x2 b = *(const u32x2*)(z + rowoff);
    const u32x2 c = hn ? *(const u32x2*)(z + rowoff + RWC) : zz;
    return unpack4(a) * *(const f32x4*)(cw + col) + unpack4(b) * *(const f32x4*)(cw + RWC + col) + unpack4(c) * *(const f32x4*)(cw + 2 * RWC + col);
}

struct EpiG1 {
    static constexpr bool PERM = true, AFTER_DRAIN = false;
    bf16_t *q, *k, *vT, *zrw; const float *rstd, *qg, *kg;
    __device__ __forceinline__ void operator()(const f32x4 (&acc)[2][2][4][2], const Unit& u, int wr, int wc, int fr, int fq) const {
        const int row0 = u.pm * BM + wr * 64 + fr;
        float rsv[2][4];
#pragma unroll
        for (int ai = 0; ai < 2; ++ai)
#pragma unroll
            for (int m = 0; m < 4; ++m) rsv[ai][m] = rstd[row0 + ai * HALF + m * 16];
        if (u.pn < 6) {
            const int kind = u.pn >> 1, head = 4 * (u.pn & 1) + wc;
            if (kind < 2) {
                bf16_t* dst = kind ? k : q; const float* gn = kind ? kg : qg;
                f32x4 g0[2][2];
#pragma unroll
                for (int bj = 0; bj < 2; ++bj)
#pragma unroll
                    for (int n = 0; n < 2; ++n) g0[bj][n] = *(const f32x4*)(gn + 32 * bj + 8 * fq + 4 * n);
#pragma unroll
                for (int ai = 0; ai < 2; ++ai)
#pragma unroll
                    for (int m = 0; m < 4; ++m) {
                        const int row = row0 + ai * HALF + m * 16; const float rs = rsv[ai][m];
                        f32x4 v[2][2]; float ss = 0.f;
#pragma unroll
                        for (int bj = 0; bj < 2; ++bj)
#pragma unroll
                            for (int n = 0; n < 2; ++n) { v[bj][n] = acc[ai][bj][m][n] * rs; const f32x4 s = v[bj][n] * v[bj][n]; ss += (s[0] + s[1]) + (s[2] + s[3]); }
                        ss += __shfl_xor(ss, 16); ss += __shfl_xor(ss, 32);
                        const float sc = rsqrtf(ss * (1.0f / 64.0f) + 1e-6f);
#pragma unroll
                        for (int bj = 0; bj < 2; ++bj)
                            *(u32x4*)(dst + (size_t)row * 512 + head * 64 + 32 * bj + 8 * fq) = pack8v(v[bj][0] * sc * g0[bj][0], v[bj][1] * sc * g0[bj][1]);
                    }
            } else {
#pragma unroll
                for (int ai = 0; ai < 2; ++ai)
#pragma unroll
                    for (int m = 0; m < 4; ++m) {
                        const int row = row0 + ai * HALF + m * 16; const float rs = rsv[ai][m];
#pragma unroll
                        for (int bj = 0; bj < 2; ++bj)
#pragma unroll
                            for (int n = 0; n < 2; ++n) {
                                const f32x4 v = acc[ai][bj][m][n] * rs; const unsigned p0 = cvt_pk_bf16(v[0], v[1]), p1 = cvt_pk_bf16(v[2], v[3]);
                                bf16_t* d = vT + (size_t)(head * 64 + 32 * bj + 8 * fq + 4 * n) * T + row;
                                d[0] = (bf16_t)(p0 & 0xffffu); d[T] = (bf16_t)(p0 >> 16); d[2 * (size_t)T] = (bf16_t)(p1 & 0xffffu); d[3 * (size_t)T] = (bf16_t)(p1 >> 16);
                            }
                    }
            }
        } else {
            const int col0 = (u.pn - 6) * BM + wc * 32 + 8 * fq;
#pragma unroll
            for (int ai = 0; ai < 2; ++ai)
#pragma unroll
                for (int m = 0; m < 4; ++m) {
                    const int row = row0 + ai * HALF + m * 16; const float rs = rsv[ai][m];
#pragma unroll
                    for (int bj = 0; bj < 2; ++bj) { const int col = col0 + bj * HALF;
                        if (col < RWC) *(u32x4*)(zrw + (size_t)row * RWC + col) = pack8v(acc[ai][bj][m][0] * rs, acc[ai][bj][m][1] * rs); }
                }
        }
    }
};
template <int MODE> struct EpiB {
    static constexpr bool PERM = true, AFTER_DRAIN = false;
    bf16_t* O; int ld; const float* rs; const bf16_t* G; int ldg;
    __device__ __forceinline__ void operator()(const f32x4 (&acc)[2][2][4][2], const Unit& u, int wr, int wc, int fr, int fq) const {
        const int row0 = u.pm * BM + wr * 64 + fr, col0 = u.pn * BM + wc * 32 + 8 * fq;
        float rr[2][4];
#pragma unroll
        for (int ai = 0; ai < 2; ++ai)
#pragma unroll
            for (int m = 0; m < 4; ++m) {
                const int row = row0 + ai * HALF + m * 16; rr[ai][m] = 1.f;
                if (MODE == 0) rr[ai][m] = rs[row];
                if (MODE == 3) { const f32x4* p = (const f32x4*)(rs + (size_t)row * 16); const f32x4 s = (p[0] + p[1]) + (p[2] + p[3]); rr[ai][m] = rsqrtf(((s[0] + s[1]) + (s[2] + s[3])) * (1.0f / 1024.0f) + 1e-6f); }
            }
#pragma unroll
        for (int ai = 0; ai < 2; ++ai)
#pragma unroll
            for (int mh = 0; mh < 2; ++mh) {
                u32x4 gq[2][2], oq[2][2];
                if (MODE == 1 || MODE == 2) {
#pragma unroll
                    for (int mm = 0; mm < 2; ++mm)
#pragma unroll
                        for (int bj = 0; bj < 2; ++bj) { const int row = row0 + ai * HALF + (2 * mh + mm) * 16;
                            gq[mm][bj] = *(const u32x4*)(G + (size_t)row * ldg + col0 + bj * HALF);
                            if (MODE == 2) oq[mm][bj] = *(const u32x4*)(O + (size_t)row * ld + col0 + bj * HALF); }
                }
#pragma unroll
                for (int mm = 0; mm < 2; ++mm)
#pragma unroll
                    for (int bj = 0; bj < 2; ++bj) {
                        const int m = 2 * mh + mm, row = row0 + ai * HALF + m * 16; const float r = rr[ai][m];
                        const size_t off = (size_t)row * ld + col0 + bj * HALF;
                        f32x4 v0 = acc[ai][bj][m][0], v1 = acc[ai][bj][m][1];
                        if (MODE == 0) {
#pragma unroll
                            for (int j = 0; j < 4; ++j) { v0[j] = sigm(v0[j] * r); v1[j] = sigm(v1[j] * r); } }
                        if (MODE == 1 || MODE == 2) { f32x4 g0, g1; unpack8(gq[mm][bj], g0, g1); v0 *= g0; v1 *= g1; }
                        if (MODE == 2) { f32x4 m0, m1; unpack8(oq[mm][bj], m0, m1); v0 += m0; v1 += m1; }
                        if (MODE == 3) {
#pragma unroll
                            for (int j = 0; j < 4; ++j) { const float a_ = fmaxf(v0[j] * r, 0.f), b_ = fmaxf(v1[j] * r, 0.f); v0[j] = a_ * a_; v1[j] = b_ * b_; } }
                        *(u32x4*)(O + off) = pack8v(v0, v1);
                    }
            }
    }
};
template <int MODE> struct EpiF {
    static constexpr bool PERM = false, AFTER_DRAIN = false;
    const float* resP; const float* resS; float* out; bf16_t* hb; float* ssq; const float* ssin; const bf16_t* r16;
    __device__ __forceinline__ void operator()(const f32x4 (&acc)[2][2][4][2], const Unit& u, int wr, int wc, int fr, int fq) const {
        const int row0 = u.pm * BM + wr * 64 + fr, col0 = u.pn * BM + wc * 32 + 4 * fq;
        float rr[2][4];
#pragma unroll
        for (int ai = 0; ai < 2; ++ai)
#pragma unroll
            for (int m = 0; m < 4; ++m) { rr[ai][m] = 1.f;
                if (MODE == 1) { const int row = row0 + ai * HALF + m * 16; const f32x4* p = (const f32x4*)(ssin + (size_t)row * 16); const f32x4 s = (p[0] + p[1]) + (p[2] + p[3]); rr[ai][m] = rsqrtf(((s[0] + s[1]) + (s[2] + s[3])) * (1.0f / 1024.0f) + 1e-6f); } }
#pragma unroll
        for (int ai = 0; ai < 2; ++ai)
#pragma unroll
            for (int mh = 0; mh < 2; ++mh) {
                u32x2 hq[2][2][2]; f32x4 oq[2][2][2];
                if (MODE == 0 || MODE == 2) {
#pragma unroll
                    for (int mm = 0; mm < 2; ++mm)
#pragma unroll
                        for (int bj = 0; bj < 2; ++bj)
#pragma unroll
                            for (int n = 0; n < 2; ++n) { const size_t off = (size_t)(row0 + ai * HALF + (2 * mh + mm) * 16) * 1024 + col0 + bj * HALF + n * 16;
                                hq[mm][bj][n] = *(const u32x2*)(hb + off); if (MODE == 2) oq[mm][bj][n] = *(const f32x4*)(out + off); }
                }
#pragma unroll
                for (int mm = 0; mm < 2; ++mm) {
                    const int m = 2 * mh + mm, row = row0 + ai * HALF + m * 16; const float r = rr[ai][m]; float ssl = 0.f;
#pragma unroll
                    for (int bj = 0; bj < 2; ++bj)
#pragma unroll
                        for (int n = 0; n < 2; ++n) {
                            const int col = col0 + bj * HALF + n * 16; const size_t off = (size_t)row * 1024 + col;
                            f32x4 v = acc[ai][bj][m][n];
                            if (MODE == 0) { v += unpack4(hq[mm][bj][n]); if (out) *(f32x4*)(out + off) = v;
                                *(u32x2*)(hb + off) = pack4v(v); const f32x4 s = v * v; ssl += (s[0] + s[1]) + (s[2] + s[3]); }
                            if (MODE == 1) {
#pragma unroll
                                for (int j = 0; j < 4; ++j) v[j] = sigm(v[j] * r);
                                *(u32x2*)(hb + off) = pack4v(v); }
                            if (MODE == 2) { const f32x4 g = unpack4(hq[mm][bj][n]); *(f32x4*)(out + off) = oq[mm][bj][n] + g * v; }
                        }
                    if (MODE == 0) { ssl += __shfl_xor(ssl, 16); ssl += __shfl_xor(ssl, 32); if (fq == 0) ssq[(size_t)row * 16 + u.pn * 4 + wc] = ssl; }
                }
            }
    }
};
DI void p0_tile_load(const float* W, int ldw, const float* gs, int mode, int col0, int tk, int tn, int tid, f32x4 (&v)[2]) {
#pragma unroll
    for (int i = 0; i < 2; ++i) {
        const int kk = (tid >> 4) + 32 * i, n = tn * 64 + (tid & 15) * 4; int col = col0 + n;
        if (mode == 1) { if (n < 1536) { const int pn = n >> 8, j = n & 255; col = 256 * pn + 64 * ((j >> 5) & 3) + 32 * (j >> 7) + (j & 31); } else if (n >= 3392) col = -1; }
        v[i] = (f32x4){0.f, 0.f, 0.f, 0.f};
        if (col >= 0) v[i] = *(const f32x4*)(W + (size_t)(tk * 64 + kk) * ldw + col);
        if (gs) v[i] *= gs[tk * 64 + kk];
    }
}
DI void p0_transpose(LAS float* tl, const float* W, int ldw, int K, int Nrows, bf16_t* dst, const float* gs, int mode, int col0, int G, int b, int tid) {
    const int ntk = K / 64, ntn = Nrows / 64, nt = ntk * ntn;
    f32x4 v[2], vn[2];
    if (b < nt) p0_tile_load(W, ldw, gs, mode, col0, b % ntk, b / ntk, tid, v);
    for (int tile = b; tile < nt; tile += G) {
        const int tk = tile % ntk, tn = tile / ntk;
#pragma unroll
        for (int i = 0; i < 2; ++i) { const int kk = (tid >> 4) + 32 * i;
#pragma unroll
            for (int j = 0; j < 4; ++j) tl[kk * 65 + (tid & 15) * 4 + j] = v[i][j]; }
        const int nx = tile + G;
        if (nx < nt) p0_tile_load(W, ldw, gs, mode, col0, nx % ntk, nx / ntk, tid, vn);
        __syncthreads();
        { const int n = tid >> 3, k8 = (tid & 7) * 8; float f[8];
#pragma unroll
          for (int j = 0; j < 8; ++j) f[j] = tl[(k8 + j) * 65 + n];
          *(u32x4*)(dst + (size_t)(tn * 64 + n) * K + tk * 64 + k8) = pack8(f); }
        __syncthreads();
        v[0] = vn[0]; v[1] = vn[1];
    }
}

DI void na_item(int item, const bf16_t* q, const bf16_t* k, const bf16_t* vT, const float* relb, bf16_t* ya, int lane) {
    asm volatile("" : "+v"(lane));
    const int cb = item & 3, h = (item >> 2) & 7, pr = item >> 5;
    const int rows = pr < 256 ? 128 : 32;
    const int r = pr < 256 ? (pr & 127) : ((pr - 256) & 31);
    const int rs0 = min(max(r - 4, 0), rows - 8);
    const int prbase = pr - r + rs0;
    const int blk = min(max(cb * 16 - 8, 0), 32);
    const int l16 = lane & 15, g = lane >> 4;
    const bf16_t* qp = q + (size_t)(pr * 64 + cb * 16 + l16) * 512 + h * 64 + 8 * g;
    const bf16x8 qf0 = *(const bf16x8*)qp, qf1 = *(const bf16x8*)(qp + 32);
    f32x4 sc[8][2];
#pragma unroll
    for (int s = 0; s < 8; ++s)
#pragma unroll
        for (int u = 0; u < 2; ++u) {
            const int tok = (prbase + s) * 64 + blk + 8 * (l16 >> 2) + 4 * u + (l16 & 3);
            const bf16_t* kp = k + (size_t)tok * 512 + h * 64 + 8 * g;
            const bf16x8 kf0 = *(const bf16x8*)kp, kf1 = *(const bf16x8*)(kp + 32);
            f32x4 a = (f32x4){0.f, 0.f, 0.f, 0.f};
            a = MFMA16(kf0, qf0, a); a = MFMA16(kf1, qf1, a);
            sc[s][u] = a;
            if (u == 1 && (s & 1)) asm volatile("" ::: "memory");
        }
    const int qc = cb * 16 + l16, cs = min(max(qc - 8, 0), 48);
    const float* rb = relb + h * 465;
    float mx = -3.0e38f;
#pragma unroll
    for (int s = 0; s < 8; ++s) {
        const int dr = rs0 + s - r + 7;
#pragma unroll
        for (int u = 0; u < 2; ++u)
#pragma unroll
            for (int j = 0; j < 4; ++j) {
                const int kc = blk + 8 * g + 4 * u + j; const bool valid = (kc >= cs) && (kc < cs + 16);
                const int dc = min(max(kc - qc + 15, 0), 30);
                float v = sc[s][u][j] * 0.125f + rb[dr * 31 + dc];
                v = valid ? v : -1.0e30f; sc[s][u][j] = v; mx = fmaxf(mx, v);
            }
    }
    mx = fmaxf(mx, __shfl_xor(mx, 16)); mx = fmaxf(mx, __shfl_xor(mx, 32));
    float sum = 0.f;
#pragma unroll
    for (int s = 0; s < 8; ++s)
#pragma unroll
        for (int u = 0; u < 2; ++u)
#pragma unroll
            for (int j = 0; j < 4; ++j) { const float p = __expf(sc[s][u][j] - mx); sc[s][u][j] = p; sum += p; }
    sum += __shfl_xor(sum, 16); sum += __shfl_xor(sum, 32);
    const float inv = 1.0f / sum;
    f32x4 o[4];
#pragma unroll
    for (int dt = 0; dt < 4; ++dt) o[dt] = (f32x4){0.f, 0.f, 0.f, 0.f};
#pragma unroll
    for (int s = 0; s < 8; ++s) {
        const u32x4 pw = pack8v(sc[s][0] * inv, sc[s][1] * inv); const bf16x8 pa = __builtin_bit_cast(bf16x8, pw);
#pragma unroll
        for (int dt = 0; dt < 4; ++dt) {
            const bf16x8 vf = *(const bf16x8*)(vT + (size_t)(h * 64 + 16 * dt + l16) * T + (prbase + s) * 64 + blk + 8 * g);
            o[dt] = MFMA16(pa, vf, o[dt]);
        }
        if (s & 1) asm volatile("" ::: "memory");
    }
#pragma unroll
    for (int dt = 0; dt < 4; ++dt)
#pragma unroll
        for (int j = 0; j < 4; ++j) {
            const unsigned p = cvt_pk_bf16(o[dt][j], 0.f);
            ya[(size_t)(pr * 64 + cb * 16 + 4 * g + j) * 512 + h * 64 + 16 * dt + l16] = (bf16_t)(p & 0xffffu);
        }
}

struct ScanArgs { const bf16_t* zrw; const float* convw; const bf16_t *wupTf, *wupTb, *aupT; const float *w0f, *w0b, *a0, *k_k, *k_a, *r_k; float* bonus; bf16_t *yf, *ybk; };
struct ScanJob { int tok0, Ls, seg0, nst, h, dir, init, store_y; float* carry; };
DI float red8(float x) {
    x += dpp_xor1(x); x += dpp_xor2(x);
    x += __int_as_float(__builtin_amdgcn_mov_dpp(__float_as_int(x), 0x141, 0xF, 0xF, true));
    return x;
}
DI void red8x4(float& a, float& b, float& c, float& d) {
    asm volatile("s_nop 1\n\t"
                 "v_add_f32_dpp %0, %0, %0 quad_perm:[1,0,3,2] row_mask:0xf bank_mask:0xf bound_ctrl:1\n\t"
                 "v_add_f32_dpp %1, %1, %1 quad_perm:[1,0,3,2] row_mask:0xf bank_mask:0xf bound_ctrl:1\n\t"
                 "v_add_f32_dpp %2, %2, %2 quad_perm:[1,0,3,2] row_mask:0xf bank_mask:0xf bound_ctrl:1\n\t"
                 "v_add_f32_dpp %3, %3, %3 quad_perm:[1,0,3,2] row_mask:0xf bank_mask:0xf bound_ctrl:1\n\t"
                 "v_add_f32_dpp %0, %0, %0 quad_perm:[2,3,0,1] row_mask:0xf bank_mask:0xf bound_ctrl:1\n\t"
                 "v_add_f32_dpp %1, %1, %1 quad_perm:[2,3,0,1] row_mask:0xf bank_mask:0xf bound_ctrl:1\n\t"
                 "v_add_f32_dpp %2, %2, %2 quad_perm:[2,3,0,1] row_mask:0xf bank_mask:0xf bound_ctrl:1\n\t"
                 "v_add_f32_dpp %3, %3, %3 quad_perm:[2,3,0,1] row_mask:0xf bank_mask:0xf bound_ctrl:1\n\t"
                 "v_add_f32_dpp %0, %0, %0 row_half_mirror row_mask:0xf bank_mask:0xf bound_ctrl:1\n\t"
                 "v_add_f32_dpp %1, %1, %1 row_half_mirror row_mask:0xf bank_mask:0xf bound_ctrl:1\n\t"
                 "v_add_f32_dpp %2, %2, %2 row_half_mirror row_mask:0xf bank_mask:0xf bound_ctrl:1\n\t"
                 "v_add_f32_dpp %3, %3, %3 row_half_mirror row_mask:0xf bank_mask:0xf bound_ctrl:1"
                 : "+v"(a), "+v"(b), "+v"(c), "+v"(d));
}
DI void team_bar(LAS unsigned* bar, unsigned& k, int lane) {
    asm volatile("s_waitcnt lgkmcnt(0)" ::: "memory");
    k += 2u;
    if (lane == 0) __hip_atomic_fetch_add(bar, 1u, __ATOMIC_RELAXED, __HIP_MEMORY_SCOPE_WORKGROUP);
    while (__hip_atomic_load(bar, __ATOMIC_RELAXED, __HIP_MEMORY_SCOPE_WORKGROUP) < k) __builtin_amdgcn_s_sleep(1);
    asm volatile("s_waitcnt lgkmcnt(0)" ::: "memory");
}
DI void conv8R(const LAS float* raw, int rr, int pc, bool hp, bool hn, const LAS float* cw, float* out) {
    const u32x4 zz = (u32x4){0u, 0u, 0u, 0u};
    u32x4 a = *(const LAS u32x4*)(raw + (rr * 40 + pc) * 4); const u32x4 b = *(const LAS u32x4*)(raw + ((rr + 1) * 40 + pc) * 4); u32x4 c = *(const LAS u32x4*)(raw + ((rr + 2) * 40 + pc) * 4);
    a = hp ? a : zz; c = hn ? c : zz;
    const f32x4 w0a = *(const LAS f32x4*)(cw), w0b = *(const LAS f32x4*)(cw + 4), w1a = *(const LAS f32x4*)(cw + 64), w1b = *(const LAS f32x4*)(cw + 68), w2a = *(const LAS f32x4*)(cw + 128), w2b = *(const LAS f32x4*)(cw + 132);
    f32x4 a0, a1, b0, b1, c0, c1; unpack8(a, a0, a1); unpack8(b, b0, b1); unpack8(c, c0, c1);
    const f32x4 o0 = a0 * w0a + b0 * w1a + c0 * w2a, o1 = a1 * w0b + b1 * w1b + c1 * w2b;
#pragma unroll
    for (int j = 0; j < 4; ++j) { out[j] = o0[j]; out[4 + j] = o1[j]; }
}
DI void scan_team(const ScanJob J, const int mem, LAS float* L, LAS float* RAW, LAS float* TB, LAS unsigned* bar, unsigned& bk, f32x4 (&SI)[4][2], const ScanArgs& A, int lane) {
    const int tok0 = J.tok0, Ls = J.Ls, h = J.h, dir = J.dir; const bool pmode = (J.init == 1);
    LAS float *LW = L, *LKK = L + 1024, *LB = L + 2048, *LKT = L + 3072, *LR = L + 4096, *LV = L + 5120;
    LAS float* YB = L + 9216;
    const bf16_t* wupT = dir ? A.wupTb : A.wupTf; const float* w0 = dir ? A.w0b : A.w0f; bf16_t* yout = dir ? A.ybk : A.yf;
    const int dwcol = 1536 + 64 * dir;
#pragma unroll
    for (int tap = 0; tap < 3; ++tap) {
#pragma unroll
        for (int vec = 0; vec < 3; ++vec) TB[(vec * 3 + tap) * 64 + lane] = A.convw[tap * RWC + vec * 512 + h * 64 + lane];
        TB[576 + tap * 64 + lane] = A.convw[tap * RWC + dwcol + lane];
        TB[576 + 192 + tap * 64 + lane] = A.convw[tap * RWC + 1664 + lane];
    }
    TB[960 + lane] = A.k_k[h * 64 + lane]; TB[1024 + lane] = A.k_a[h * 64 + lane]; TB[1088 + lane] = A.r_k[h * 64 + lane];
    TB[1152 + lane] = w0[h * 64 + lane]; TB[1216 + lane] = A.a0[h * 64 + lane];
    f32x2 S[4][4];
#pragma unroll
    for (int r = 0; r < 4; ++r)
#pragma unroll
        for (int j = 0; j < 2; ++j) { f32x4 z = SI[r][j];
            if (J.init != 2) {
#pragma unroll
                for (int e = 0; e < 4; ++e) z[e] = (pmode && (32 * mem + 4 * (lane >> 3) + r == 8 * (lane & 7) + 4 * j + e)) ? 1.f : 0.f; }
            S[r][2 * j] = (f32x2){z[0], z[1]}; S[r][2 * j + 1] = (f32x2){z[2], z[3]}; }
    int prow[6], pcol[6];
#pragma unroll
    for (int i = 0; i < 6; ++i) { const int p = (mem * 6 + i) * 64 + lane, row = p / 40, rem = p - row * 40, g = rem >> 3, ch = rem & 7;
        prow[i] = row > 17 ? 17 : row; pcol[i] = (g == 0 ? h * 64 : g == 1 ? 512 + h * 64 : g == 2 ? 1024 + h * 64 : g == 3 ? dwcol : 1664) + 8 * ch; }
#define SC_DMA(T0) do { _Pragma("unroll") for (int i = 0; i < 6; ++i) { int tr_ = (T0) - 1 + prow[i]; tr_ = tr_ < tok0 ? tok0 : (tr_ > tok0 + Ls - 1 ? tok0 + Ls - 1 : tr_); \
            __builtin_amdgcn_global_load_lds((const unsigned*)(A.zrw + (size_t)tr_ * RWC + pcol[i]), (LAS unsigned*)(RAW + (mem * 6 + i) * 256), 16, 0, 0); } } while (0)
    bf16x8 AF[2][4];
    { const bf16_t* wt0 = mem ? A.aupT : wupT;
#pragma unroll
      for (int ks = 0; ks < 2; ++ks)
#pragma unroll
          for (int mt = 0; mt < 4; ++mt) AF[ks][mt] = *(const bf16x8*)(wt0 + (size_t)(h * 64 + 16 * mt + (lane & 15)) * 64 + 32 * ks + 8 * (lane >> 4)); }
    const int nch = J.nst / 16;
    SC_DMA(J.seg0 + (dir ? nch - 1 : 0) * 16);
    asm volatile("s_waitcnt vmcnt(0)" ::: "memory");
    team_bar(bar, bk, lane);
    for (int ci = 0; ci < nch; ++ci) {
        const int c = dir ? nch - 1 - ci : ci; const int t0 = J.seg0 + c * 16;
        int ln = lane; asm volatile("" : "+v"(ln));
        {
            const int tk = ln & 15, hq = ln >> 4; const int t = t0 + tk; const int pos = t - tok0; const bool hp = pos > 0, hn = pos < Ls - 1;
            f32x4 acc[4];
#pragma unroll
            for (int mt = 0; mt < 4; ++mt) acc[mt] = (f32x4){0.f, 0.f, 0.f, 0.f};
#pragma unroll
            for (int ks = 0; ks < 2; ++ks) {
                const int kq = 32 * ks + 8 * hq; float x[8];
                conv8R(RAW, tk, (mem ? 32 : 24) + 4 * ks + hq, hp, hn, TB + 576 + mem * 192 + kq, x);
                if (mem == 0) {
#pragma unroll
                    for (int j = 0; j < 8; ++j) x[j] = 1.0f - 2.0f * __builtin_amdgcn_rcpf(__expf(2.0f * x[j]) + 1.0f); }
                const u32x4 pw = pack8(x); const bf16x8 bfrag = __builtin_bit_cast(bf16x8, pw);
#pragma unroll
                for (int mt = 0; mt < 4; ++mt) acc[mt] = MFMA16(AF[ks][mt], bfrag, acc[mt]);
            }
#pragma unroll
            for (int mt = 0; mt < 4; ++mt) {
                const int cc = 16 * mt + 4 * hq; const f32x4 bias = *(const LAS f32x4*)(TB + 1152 + mem * 64 + cc); f32x4 o;
#pragma unroll
                for (int j = 0; j < 4; ++j) { const float sg = sigm(bias[j] + acc[mt][j]); o[j] = mem ? sg : __expf(-0.606531f * sg); }
                *(LAS f32x4*)((mem ? LB : LW) + tk * 64 + cc) = o;
            }
        }
        team_bar(bar, bk, lane);
        {
            const int tk = 8 * mem + (ln >> 3), c0 = 8 * (ln & 7); const int t = t0 + tk; const int pos = t - tok0; const bool hp = pos > 0, hn = pos < Ls - 1;
            float rc[8], kc8[8], vc[8];
            conv8R(RAW, tk, (ln & 7), hp, hn, TB + c0, rc);
            conv8R(RAW, tk, 8 + (ln & 7), hp, hn, TB + 192 + c0, kc8);
            conv8R(RAW, tk, 16 + (ln & 7), hp, hn, TB + 384 + c0, vc);
            const int o = tk * 64 + c0;
            const f32x4 a_lo = *(const LAS f32x4*)(LB + o), a_hi = *(const LAS f32x4*)(LB + o + 4);
            const f32x4 kk_lo = *(const LAS f32x4*)(TB + 960 + c0), kk_hi = *(const LAS f32x4*)(TB + 960 + c0 + 4);
            const f32x4 ka_lo = *(const LAS f32x4*)(TB + 1024 + c0), ka_hi = *(const LAS f32x4*)(TB + 1024 + c0 + 4);
            const f32x4 rk_lo = *(const LAS f32x4*)(TB + 1088 + c0), rk_hi = *(const LAS f32x4*)(TB + 1088 + c0 + 4);
            f32x4 kr[2], kt[2], av[2]; float n2 = 0.f, bon = 0.f;
#pragma unroll
            for (int j = 0; j < 8; ++j) {
                const float a = j < 4 ? a_lo[j & 3] : a_hi[j & 3], kkw = j < 4 ? kk_lo[j & 3] : kk_hi[j & 3], kaw = j < 4 ? ka_lo[j & 3] : ka_hi[j & 3], rkw = j < 4 ? rk_lo[j & 3] : rk_hi[j & 3];
                const float kraw = kc8[j] * kkw; n2 += kraw * kraw;
                const float ktv = kc8[j] * (1.0f + (a - 1.0f) * kaw); bon += rc[j] * ktv * rkw;
                kr[j >> 2][j & 3] = kraw; kt[j >> 2][j & 3] = ktv; av[j >> 2][j & 3] = a;
            }
            n2 = red8(n2); bon = red8(bon);
            const float inv = 1.0f / fmaxf(sqrtf(n2), 1e-12f);
            *(LAS f32x4*)(LR + o) = (f32x4){rc[0], rc[1], rc[2], rc[3]}; *(LAS f32x4*)(LR + o + 4) = (f32x4){rc[4], rc[5], rc[6], rc[7]};
            if (pmode) {
#pragma unroll
                for (int j = 0; j < 8; ++j) vc[j] = 0.f; }
            *(LAS f32x4*)(LV + o) = (f32x4){vc[0], vc[1], vc[2], vc[3]}; *(LAS f32x4*)(LV + o + 4) = (f32x4){vc[4], vc[5], vc[6], vc[7]};
            *(LAS f32x4*)(LKT + o) = kt[0]; *(LAS f32x4*)(LKT + o + 4) = kt[1];
            const f32x4 k0 = kr[0] * inv, k1 = kr[1] * inv;
            *(LAS f32x4*)(LKK + o) = k0; *(LAS f32x4*)(LKK + o + 4) = k1;
            *(LAS f32x4*)(LB + o) = k0 * av[0]; *(LAS f32x4*)(LB + o + 4) = k1 * av[1];
            if (dir == 0 && (ln & 7) == 0 && !pmode) A.bonus[(size_t)t * 8 + h] = bon;
        }
        team_bar(bar, bk, lane);
        if (ci + 1 < nch) { const int cn = dir ? nch - 2 - ci : ci + 1; SC_DMA(J.seg0 + cn * 16); }
        {
            const int kc = ln & 7, rg = ln >> 3;
#define SC_LOAD(C, ST) do { const int tt_ = dir ? 15 - (ST) : (ST); const int base_ = tt_ * 64 + 8 * kc; \
                C[0] = *(const LAS f32x4*)(LKK + base_); C[1] = *(const LAS f32x4*)(LKK + base_ + 4); C[2] = *(const LAS f32x4*)(LW + base_); C[3] = *(const LAS f32x4*)(LW + base_ + 4); \
                C[4] = *(const LAS f32x4*)(LB + base_); C[5] = *(const LAS f32x4*)(LB + base_ + 4); C[6] = *(const LAS f32x4*)(LKT + base_); C[7] = *(const LAS f32x4*)(LKT + base_ + 4); \
                C[8] = *(const LAS f32x4*)(LR + base_); C[9] = *(const LAS f32x4*)(LR + base_ + 4); C[10] = *(const LAS f32x4*)(LV + tt_ * 64 + 32 * mem + 4 * rg); } while (0)
#define SC_P(C, q, i) ((f32x2){C[2 * (q) + ((i) >> 1)][2 * ((i) & 1)], C[2 * (q) + ((i) >> 1)][2 * ((i) & 1) + 1]})
#define SC_STEP(C, ST) do { const int tt_ = dir ? 15 - (ST) : (ST); float sa[4], y[4]; f32x2 q_[4]; \
                  \
                _Pragma("unroll") for (int r = 0; r < 4; ++r) q_[r] = S[r][0] * SC_P(C, 0, 0); \
                _Pragma("unroll") for (int i = 1; i < 4; ++i) { _Pragma("unroll") for (int r = 0; r < 4; ++r) q_[r] += S[r][i] * SC_P(C, 0, i); } \
                _Pragma("unroll") for (int r = 0; r < 4; ++r) sa[r] = -(q_[r].x + q_[r].y); \
                red8x4(sa[0], sa[1], sa[2], sa[3]); \
                _Pragma("unroll") for (int i = 0; i < 4; ++i) { f32x2 t_[4]; \
                    _Pragma("unroll") for (int r = 0; r < 4; ++r) t_[r] = S[r][i] * SC_P(C, 1, i); \
                    _Pragma("unroll") for (int r = 0; r < 4; ++r) t_[r] += (f32x2){sa[r], sa[r]} * SC_P(C, 2, i); \
                    _Pragma("unroll") for (int r = 0; r < 4; ++r) t_[r] += (f32x2){C[10][r], C[10][r]} * SC_P(C, 3, i); \
                    _Pragma("unroll") for (int r = 0; r < 4; ++r) { S[r][i] = t_[r]; if (i == 0) q_[r] = t_[r] * SC_P(C, 4, i); else q_[r] += t_[r] * SC_P(C, 4, i); } } \
                if (sy) { _Pragma("unroll") for (int r = 0; r < 4; ++r) y[r] = q_[r].x + q_[r].y; \
                    red8x4(y[0], y[1], y[2], y[3]); \
                    if (kc == 0) *(LAS f32x4*)(YB + tt_ * 64 + 32 * mem + 4 * rg) = (f32x4){y[0], y[1], y[2], y[3]}; } } while (0)
            const bool sy = (J.store_y != 0);
            f32x4 CA[11], CB[11];
            SC_LOAD(CA, 0);
            for (int st = 0; st < 16; st += 2) {
                SC_LOAD(CB, st + 1); asm volatile("" ::: "memory");
                SC_STEP(CA, st);
                if (st + 2 < 16) SC_LOAD(CA, st + 2);
                asm volatile("" ::: "memory");
                SC_STEP(CB, st + 1);
            }
#undef SC_LOAD
#undef SC_P
#undef SC_STEP
        }
        asm volatile("s_waitcnt vmcnt(0)" ::: "memory");
        if (J.store_y) {
            wave_lds_fence();
            const int tq = ln >> 2, pq = ln & 3; const LAS float* yp = YB + tq * 64 + 32 * mem + 8 * pq;
            *(u32x4*)(yout + (size_t)(t0 + tq) * 512 + h * 64 + 32 * mem + 8 * pq) = pack8v(*(const LAS f32x4*)yp, *(const LAS f32x4*)(yp + 4));
        }
        team_bar(bar, bk, lane);
    }
#undef SC_DMA
    if (J.carry) {
#pragma unroll
        for (int r = 0; r < 4; ++r)
#pragma unroll
            for (int j = 0; j < 2; ++j) *(f32x4*)(J.carry + (32 * mem + 4 * (lane >> 3) + r) * 64 + 8 * (lane & 7) + 4 * j) = (f32x4){S[r][2 * j].x, S[r][2 * j].y, S[r][2 * j + 1].x, S[r][2 * j + 1].y};
    }
}
DI void scan_carry_in(int c, int s, int nsc, const float* CU, const float* CP, const int mem, f32x4 (&S)[4][2], LAS float* PT, int lane) {
    const int rg = lane >> 3, kc = lane & 7;
    { const float* U0 = CU + (size_t)(c * nsc) * 4096;
#pragma unroll
      for (int r = 0; r < 4; ++r)
#pragma unroll
          for (int j = 0; j < 2; ++j) S[r][j] = *(const f32x4*)(U0 + (32 * mem + 4 * rg + r) * 64 + 8 * kc + 4 * j); }
    for (int q = 1; q < s; ++q) {
#pragma unroll
        for (int j = 0; j < 2; ++j)
#pragma unroll
            for (int e = 0; e < 4; ++e) *(LAS f32x4*)(PT + (8 * kc + 4 * j + e) * 32 + 4 * rg) = (f32x4){S[0][j][e], S[1][j][e], S[2][j][e], S[3][j][e]};
        wave_lds_fence();
        const float* Pj = CP + (size_t)(c * nsc + q) * 4096; const float* Uj = CU + (size_t)(c * nsc + q) * 4096;
#pragma unroll
        for (int r = 0; r < 4; ++r)
#pragma unroll
            for (int j = 0; j < 2; ++j) S[r][j] = *(const f32x4*)(Uj + (32 * mem + 4 * rg + r) * 64 + 8 * kc + 4 * j);
#pragma unroll 1
        for (int m0 = 0; m0 < 64; m0 += 8) {
            f32x4 pv[8][2];
#pragma unroll
            for (int u = 0; u < 8; ++u)
#pragma unroll
                for (int j = 0; j < 2; ++j) pv[u][j] = *(const f32x4*)(Pj + (m0 + u) * 64 + 8 * kc + 4 * j);
#pragma unroll
            for (int u = 0; u < 8; ++u) {
            const int m = m0 + u;
            const f32x4 sv = *(const LAS f32x4*)(PT + m * 32 + 4 * rg);
#pragma unroll
            for (int j = 0; j < 2; ++j) { const f32x4 p = pv[u][j];
#pragma unroll
                for (int r = 0; r < 4; ++r) S[r][j] += p * sv[r]; }
            }
        }
        wave_lds_fence();
    }
}

DI void post_item(int item, const bf16_t* zrw, const float* convw, const bf16_t* gupT, const bf16_t* yf, const bf16_t* ybk, const float* bonus, const float* lnw, const float* lnb, bf16_t* yb, int lane) {
    asm volatile("" : "+v"(lane));
    const int h = item & 7, tile = item >> 3, tk = lane & 31, hh = lane >> 5; const int t = tile * 32 + tk;
    const int pos = t < TP ? (t & 8191) : (t & 2047), Ls = t < TP ? 8192 : 2048; const bool hp = pos > 0, hn = pos < Ls - 1;
    f32x16 acc[2];
#pragma unroll
    for (int mt = 0; mt < 2; ++mt)
#pragma unroll
        for (int i = 0; i < 16; ++i) acc[mt][i] = 0.f;
#pragma unroll
    for (int ks = 0; ks < 8; ++ks) {
        const int col = 1728 + 16 * ks + 8 * hh; float x[8];
        conv8(zrw, (size_t)t * RWC + col, hp, hn, convw, col, x);
#pragma unroll
        for (int j = 0; j < 8; ++j) x[j] = sigm(x[j]);
        const u32x4 pw = pack8(x); const bf16x8 bfrag = __builtin_bit_cast(bf16x8, pw);
#pragma unroll
        for (int mt = 0; mt < 2; ++mt) {
            const bf16x8 afrag = *(const bf16x8*)(gupT + (size_t)(h * 64 + 32 * mt + tk) * 128 + 16 * ks + 8 * hh);
            acc[mt] = MFMA32(afrag, bfrag, acc[mt]);
        }
    }
    f32x4 y[2][4]; float sum = 0.f;
#pragma unroll
    for (int mt = 0; mt < 2; ++mt)
#pragma unroll
        for (int gi = 0; gi < 4; ++gi) {
            const size_t off = (size_t)t * 512 + h * 64 + 32 * mt + 8 * gi + 4 * hh;
            y[mt][gi] = unpack4(*(const u32x2*)(yf + off)) + unpack4(*(const u32x2*)(ybk + off));
            sum += (y[mt][gi][0] + y[mt][gi][1]) + (y[mt][gi][2] + y[mt][gi][3]);
        }
    sum += __shfl_xor(sum, 32); const float mu = sum * (1.0f / 64.0f); float qv = 0.f;
#pragma unroll
    for (int mt = 0; mt < 2; ++mt)
#pragma unroll
        for (int gi = 0; gi < 4; ++gi) { y[mt][gi] -= mu; const f32x4 s = y[mt][gi] * y[mt][gi]; qv += (s[0] + s[1]) + (s[2] + s[3]); }
    qv += __shfl_xor(qv, 32); const float rs = rsqrtf(qv * (1.0f / 64.0f) + 64e-5f);
    const float bn = bonus[(size_t)t * 8 + h];
#pragma unroll
    for (int mt = 0; mt < 2; ++mt)
#pragma unroll
        for (int gi = 0; gi < 4; ++gi) {
            const int hc = h * 64 + 32 * mt + 8 * gi + 4 * hh;
            const f32x4 v4 = conv4(zrw, (size_t)t * RWC + 1024 + hc, hp, hn, convw, 1024 + hc);
            const f32x4 lw = *(const f32x4*)(lnw + hc), lb = *(const f32x4*)(lnb + hc);
            f32x4 g4;
#pragma unroll
            for (int j = 0; j < 4; ++j) g4[j] = acc[mt][4 * gi + j];
            const f32x4 o = (y[mt][gi] * rs * lw + lb + v4 * bn) * g4;
            *(u32x2*)(yb + (size_t)t * 512 + hc) = pack4v(o);
        }
}
struct Params { const float* in[31]; float* out; unsigned char* ws; int ph_lo, ph_hi; };
constexpr int NPH = 10, NSB = 160;
__global__ void __launch_bounds__(512) mega(Params P) {
    extern __shared__ __attribute__((aligned(16))) unsigned char lds_raw[];
    PG8_LAS unsigned char* lds = (PG8_LAS unsigned char*)lds_raw;
    cg::grid_group grid = cg::this_grid();
    const int wid = __builtin_amdgcn_readfirstlane(threadIdx.x >> 6), b = blockIdx.x, G = gridDim.x;
    unsigned char* ws = P.ws;
    bf16_t *W1T = (bf16_t*)(ws + O_W1T), *W2T = (bf16_t*)(ws + O_W2T), *WpgT = (bf16_t*)(ws + O_WPGT), *WpleT = (bf16_t*)(ws + O_WPLET), *gupT = (bf16_t*)(ws + O_GUPT),
           *wupTf = (bf16_t*)(ws + O_WUPF), *wupTb = (bf16_t*)(ws + O_WUPB), *aupT = (bf16_t*)(ws + O_AUPT), *xb = (bf16_t*)(ws + O_XB), *zrw = (bf16_t*)(ws + O_ZRW),
           *ya = (bf16_t*)(ws + O_YA), *yf = (bf16_t*)(ws + O_YF), *ybk = (bf16_t*)(ws + O_YBK), *yb = (bf16_t*)(ws + O_YB), *Gb = (bf16_t*)(ws + O_G), *MG = (bf16_t*)(ws + O_MG),
           *hid = (bf16_t*)(ws + O_HID), *G7 = (bf16_t*)(ws + O_G7), *pb = (bf16_t*)(ws + O_PB), *WinT = (bf16_t*)(ws + O_WINT), *WgT = (bf16_t*)(ws + O_WGT),
           *WaT = (bf16_t*)(ws + O_WAT), *WbT = (bf16_t*)(ws + O_WBT), *WoT = (bf16_t*)(ws + O_WOT);
    float *rstd1 = (float*)(ws + O_RSTD1), *bonus = (float*)(ws + O_BONUS), *ssq2 = (float*)(ws + O_SSQ2), *ssq3 = (float*)(ws + O_SSQ3);
    unsigned* ctr = (unsigned*)(ws + O_CTR);
    bf16_t *qb = (bf16_t*)P.out, *kb = qb + (size_t)T * 512, *vT = kb + (size_t)T * 512;
    const int lo = P.ph_lo, hi = P.ph_hi;
    XcdBarrier xbar;
    { volatile LAS unsigned* st = (volatile LAS unsigned*)((LAS float*)lds + 34576); int l_; asm volatile("v_mbcnt_lo_u32_b32 %0, -1, 0\n\tv_mbcnt_hi_u32_b32 %0, -1, %0" : "=v"(l_));
      const bool ld_ = (wid == 0 && l_ == 0); if (ld_) { st[0] = 0u; st[1] = 0u; }
      __syncthreads();
      xbar.bar = (unsigned*)(ws + O_BAR); xbar.x = xb_xcc_id(); xbar.st = st; if (ld_) (void)xb_add(&xbar.bar[XB_XCNT(xbar.x)], 1u); }
#define IN(k) (lo <= (k) && (k) < hi)
#define GET_TID() int lane; asm volatile("v_mbcnt_lo_u32_b32 %0, -1, 0\n\tv_mbcnt_hi_u32_b32 %0, -1, %0" : "=v"(lane)); const int tid = wid * 64 + lane; (void)tid
#define GBAR() do { int l_; asm volatile("v_mbcnt_lo_u32_b32 %0, -1, 0\n\tv_mbcnt_hi_u32_b32 %0, -1, %0" : "=v"(l_)); xcd_barrier(xbar, wid == 0 && l_ == 0); } while (0)
#define SEAM(k) do { if (IN(k) && IN((k) + 1)) { if (hi > NPH) grid.sync(); else GBAR(); } } while (0)

    if (IN(0)) {
        GET_TID();
        LAS float* tl = (LAS float*)lds;
        p0_transpose(tl, P.in[5], 5440, 1024, 3584, WinT, P.in[4], 1, 0, G, b, tid);
        p0_transpose(tl, P.in[5], 5440, 1024, 2048, WgT, P.in[4], 0, 3392, G, b, tid);
        p0_transpose(tl, P.in[22], 1024, 512, 1024, WaT, nullptr, 0, 0, G, b, tid);
        p0_transpose(tl, P.in[23], 1024, 512, 1024, WbT, nullptr, 0, 0, G, b, tid);
        p0_transpose(tl, P.in[24], 1024, 1024, 1024, WoT, nullptr, 0, 0, G, b, tid);
        p0_transpose(tl, P.in[26], 4096, 1024, 4096, W1T, P.in[25], 0, 0, G, b, tid);
        p0_transpose(tl, P.in[27], 1024, 4096, 1024, W2T, nullptr, 0, 0, G, b, tid);
        p0_transpose(tl, P.in[30], 1024, 1024, 1024, WpgT, P.in[29], 0, 0, G, b, tid);
        p0_transpose(tl, P.in[28], 1024, 256, 1024, WpleT, nullptr, 0, 0, G, b, tid);
        p0_transpose(tl, P.in[16], 512, 128, 512, gupT, nullptr, 0, 0, G, b, tid);
        p0_transpose(tl, P.in[11], 512, 64, 512, wupTf, nullptr, 0, 0, G, b, tid);
        p0_transpose(tl, P.in[13], 512, 64, 512, wupTb, nullptr, 0, 0, G, b, tid);
        p0_transpose(tl, P.in[15], 512, 64, 512, aupT, nullptr, 0, 0, G, b, tid);
        for (int row0 = b * 8 + wid; row0 < T; row0 += 2 * G * 8) {
            f32x4 v[2][4]; float ss[2];
#pragma unroll
            for (int u = 0; u < 2; ++u) { const int row = row0 + u * G * 8; const float* xr = row < TP ? P.in[0] + (size_t)row * 1024 : P.in[1] + (size_t)(row - TP) * 1024;
#pragma unroll
                for (int j = 0; j < 4; ++j) v[u][j] = *(const f32x4*)(xr + j * 256 + lane * 4); }
#pragma unroll
            for (int u = 0; u < 2; ++u) { const int row = row0 + u * G * 8; ss[u] = 0.f;
#pragma unroll
                for (int j = 0; j < 4; ++j) { const f32x4 s = v[u][j] * v[u][j]; ss[u] += (s[0] + s[1]) + (s[2] + s[3]); }
#pragma unroll
                for (int o = 32; o >= 1; o >>= 1) ss[u] += __shfl_xor(ss[u], o);
#pragma unroll
                for (int j = 0; j < 4; ++j) *(u32x2*)(xb + (size_t)row * 1024 + j * 256 + lane * 4) = pack4v(v[u][j]);
                if (lane == 0) rstd1[row] = rsqrtf(ss[u] * (1.0f / 1024.0f) + 1e-6f); }
        }
        if (b == 0 && tid < 8) ctr[64 * tid] = 0u;
    }
    SEAM(0);
    if (IN(1)) {
        GET_TID();
        Gemm g{xb, WinT, T, 3584, 1024}; StaticOrder S; S.init(T, 3584, G, b);
        EpiG1 E{qb, kb, vT, zrw, rstd1, P.in[7], P.in[8]};
        gemm_phase<EpiG1, StaticOrder>(lds, g, S, E, nullptr, tid);
    }
    SEAM(1);
    if (IN(2)) {
        GET_TID();
        ScanArgs SA{zrw, P.in[6], wupTf, wupTb, aupT, P.in[10], P.in[12], P.in[14], P.in[17], P.in[18], P.in[19], bonus, yf, ybk};
        float *CU = (float*)(ws + O_YB), *CP = CU + (size_t)256 * 4096, *CS = CP + (size_t)256 * 4096;
        const int sl = wid % 3, mem = wid / 3;
        LAS float* Lw = (LAS float*)lds + sl * 11520; LAS float* RAWw = Lw + 6144; LAS float* TBw = Lw + 10240;
        f32x4 SI[4][2];
#pragma unroll
        for (int r = 0; r < 4; ++r) { SI[r][0] = (f32x4){0.f, 0.f, 0.f, 0.f}; SI[r][1] = (f32x4){0.f, 0.f, 0.f, 0.f}; }
        LAS unsigned* bars = (LAS unsigned*)((LAS float*)lds + 34560); unsigned bk = 0u;
        if (tid < 3) bars[tid] = 0u;
        __syncthreads();
        {
            const int slot = sl * G + b;
            if (wid < 6 && slot < 672) {
                ScanJob J; J.nst = 1024;
                if (slot < 416) { int c, s, pm; if (slot < 224) { c = slot / 7; s = slot % 7; pm = 0; } else { const int j = slot - 224; c = j / 6; s = 1 + j % 6; pm = 1; }
                    J.tok0 = (c >> 4) * 8192; J.Ls = 8192; J.h = (c >> 1) & 7; J.dir = c & 1; J.seg0 = J.tok0 + (J.dir ? 7 - s : s) * 1024;
                    J.init = pm; J.store_y = (!pm && s == 0) ? 1 : 0; J.carry = (pm ? CP : CU) + (size_t)(c * 8 + s) * 4096; }
                else { const int c = slot - 416; J.tok0 = TP + (c >> 4) * 2048; J.Ls = 2048; J.h = (c >> 1) & 7; J.dir = c & 1; J.seg0 = J.tok0 + (J.dir ? 1 : 0) * 1024; J.init = 0; J.store_y = 1; J.carry = CS + (size_t)c * 4096; }
                scan_team(J, mem, Lw, RAWw, TBw, bars + sl, bk, SI, SA, lane);
            }
            {
                const unsigned xq = xb_xcc_id() & 7u;
                for (unsigned kq = 0; kq < 8u; ++kq) {
                    const unsigned qx = (xq + kq) & 7u;
                    for (;;) {
                        unsigned idx = 0; if (lane == 0) idx = atomicAdd(ctr + 64 * qx, 1u);
                        idx = __builtin_amdgcn_readfirstlane(idx);
                        if (idx >= 3072u) break;
                        na_item((int)(qx * 3072u + idx), qb, kb, vT, P.in[9], ya, lane);
                    }
                }
            }
        }
        GBAR();
        if (tid < 3) bars[tid] = 0u;
        bk = 0u;
        __syncthreads();
        if (b < NSB) {
            const int slot = sl * NSB + b;
            if (wid < 6 && slot < 480) {
                ScanJob J; J.nst = 1024; J.init = 2; J.store_y = 1; J.carry = nullptr;
                LAS float* PTw = Lw + (mem & 1) * 2048;
                if (slot < 224) { const int c = slot / 7, s = 1 + slot % 7; J.tok0 = (c >> 4) * 8192; J.Ls = 8192; J.h = (c >> 1) & 7; J.dir = c & 1; J.seg0 = J.tok0 + (J.dir ? 7 - s : s) * 1024;
                    scan_carry_in(c, s, 8, CU, CP, mem, SI, PTw, lane); }
                else { const int c = slot - 224; J.tok0 = TP + (c >> 4) * 2048; J.Ls = 2048; J.h = (c >> 1) & 7; J.dir = c & 1; J.seg0 = J.tok0 + (J.dir ? 0 : 1) * 1024;
                    scan_carry_in(c, 1, 1, CS, CS, mem, SI, PTw, lane); }
                team_bar(bars + sl, bk, lane);
                scan_team(J, mem, Lw, RAWw, TBw, bars + sl, bk, SI, SA, lane);
            }
        } else {
            Gemm g{xb, WgT, T, 2048, 1024}; StaticOrder S; S.init(T, 2048, G - NSB, b - NSB);
            EpiB<0> E{(bf16_t*)P.out, 2048, rstd1, nullptr, 0};
            gemm_phase<EpiB<0>, StaticOrder>(lds, g, S, E, nullptr, tid);
        }
    }
    SEAM(2);
    if (IN(3)) {
        GET_TID();
        for (int item = b * 8 + wid; item < 12288; item += G * 8) post_item(item, zrw, P.in[6], gupT, yf, ybk, bonus, P.in[20], P.in[21], yb, lane);
    }
    SEAM(3);
    if (IN(4)) {
        GET_TID();
        StaticOrder S; S.init(T, 1024, G, b);
        const bf16_t* G2 = (const bf16_t*)P.out;
        { Gemm g{ya, WaT, T, 1024, 512}; EpiB<1> E{MG, 1024, nullptr, G2, 2048}; gemm_phase<EpiB<1>, StaticOrder>(lds, g, S, E, nullptr, tid); }
        { Gemm g{yb, WbT, T, 1024, 512}; EpiB<2> E{MG, 1024, nullptr, G2 + 1024, 2048}; gemm_phase<EpiB<2>, StaticOrder>(lds, g, S, E, nullptr, tid); }
    }
    SEAM(4);
    if (IN(5)) {
        GET_TID();
        Gemm g{MG, WoT, T, 1024, 1024}; StaticOrder S; S.init(T, 1024, G, b);
        EpiF<0> E{nullptr, nullptr, nullptr, xb, ssq2, nullptr, nullptr};
        gemm_phase<EpiF<0>, StaticOrder>(lds, g, S, E, nullptr, tid);
    }
    SEAM(5);
    if (IN(6)) {
        GET_TID();
        Gemm g{xb, W1T, T, 4096, 1024}; StaticOrder S; S.init(T, 4096, G, b);
        EpiB<3> E{hid, 4096, ssq2, nullptr, 0};
        gemm_phase<EpiB<3>, StaticOrder>(lds, g, S, E, nullptr, tid);
    }
    SEAM(6);
    if (IN(7)) {
        GET_TID();
        Gemm g{hid, W2T, T, 1024, 4096}; StaticOrder S; S.init(T, 1024, G, b);
        EpiF<0> E{nullptr, nullptr, P.out, xb, ssq3, nullptr, nullptr};
        gemm_phase<EpiF<0>, StaticOrder>(lds, g, S, E, nullptr, tid);
    }
    SEAM(7);
    if (IN(8)) {
        GET_TID();
        Gemm g{xb, WpgT, T, 1024, 1024}; StaticOrder S; S.init(T, 1024, G, b);
        EpiF<1> E{nullptr, nullptr, nullptr, G7, nullptr, ssq3, nullptr};
        gemm_phase<EpiF<1>, StaticOrder>(lds, g, S, E, nullptr, tid);
        for (int i = b * 512 + tid; i < T * 32; i += G * 512) {
            const int row = i >> 5, c8 = (i & 31) * 8;
            const float* src = row < TP ? P.in[2] + (size_t)row * 256 + c8 : P.in[3] + (size_t)(row - TP) * 256 + c8;
            *(u32x4*)(pb + (size_t)row * 256 + c8) = pack8v(*(const f32x4*)src, *(const f32x4*)(src + 4));
        }
    }
    SEAM(8);
    if (IN(9)) {
        GET_TID();
        Gemm g{pb, WpleT, T, 1024, 256}; StaticOrder S; S.init(T, 1024, G, b);
        EpiF<2> E{nullptr, nullptr, P.out, G7, nullptr, nullptr, xb};
        gemm_phase<EpiF<2>, StaticOrder>(lds, g, S, E, nullptr, tid);
    }
#undef IN
#undef SEAM
}

extern "C" void kernel_launch(void* const* d_in, const int* in_sizes, int n_in, void* d_out, int out_size, void* d_ws, size_t ws_size, hipStream_t stream) {
    static int grid_blocks = 0;
    if (grid_blocks == 0) {
        if (n_in != 31 || out_size != T * 1024 || ws_size < WS_NEED) { fprintf(stderr, "kernel_launch: unexpected shapes (n_in %d out %d ws %zu)\n", n_in, out_size, ws_size); grid_blocks = -1; return; }
        int dev = 0, cus = 0, per_cu = 0;
        hipGetDevice(&dev); hipDeviceGetAttribute(&cus, hipDeviceAttributeMultiprocessorCount, dev);
        if (hipFuncSetAttribute((const void*)mega, hipFuncAttributeMaxDynamicSharedMemorySize, LDS_BYTES) != hipSuccess) { fprintf(stderr, "kernel_launch: hipFuncSetAttribute failed\n"); grid_blocks = -1; return; }
        hipOccupancyMaxActiveBlocksPerMultiprocessor(&per_cu, (const void*)mega, 512, LDS_BYTES);
        if (per_cu < 1) { fprintf(stderr, "kernel_launch: occupancy query says %d blocks per CU\n", per_cu); grid_blocks = -1; return; }
        grid_blocks = cus;
    }
    if (grid_blocks < 0) return;
    Params p{};
    for (int i = 0; i < 31; ++i) p.in[i] = (const float*)d_in[i];
    p.out = (float*)d_out; p.ws = (unsigned char*)d_ws;
    if (hipMemsetAsync((unsigned char*)d_ws + O_BAR, 0, XCD_BAR_WORDS * 4, stream) != hipSuccess) { fprintf(stderr, "kernel_launch: memset of the barrier words failed\n"); return; }
#if defined(SPLIT_LAUNCH)
    for (int ph = 0; ph < NPH; ++ph) { p.ph_lo = ph; p.ph_hi = ph + 1; hipLaunchKernelGGL(mega, dim3(grid_blocks), dim3(512), LDS_BYTES, stream, p); }
#else
    p.ph_lo = 0; p.ph_hi = NPH;
    void* args[] = {&p};
    hipError_t e = hipLaunchCooperativeKernel((const void*)mega, dim3(grid_blocks), dim3(512), args, LDS_BYTES, stream);
    if (e != hipSuccess) fprintf(stderr, "cooperative launch failed: %s (grid %d)\n", hipGetErrorString(e), grid_blocks);
#endif
}
```
